# Optimizing an MI355X kernel written in HIP

```python
import jax, jax.numpy as jnp
from jax import lax
import numpy as np

D_MODEL = 1024
BATCH = 8
SEQ = 4096
DEPTH = 4

N_MIXERS = 2
N_A = (DEPTH + 1) // 2
N_B = DEPTH // 2

D_RNN = 3 * D_MODEL // 2
LRU_HEADS = 12
LRU_BW = D_RNN // LRU_HEADS
CONV_WIDTH = 4
LRU_C = 8.0

D_POOL = D_MODEL
POOL_WINDOWS = (2, 4, 8, 16)
POOL_GROUPS = len(POOL_WINDOWS)
POOL_GW = D_POOL // POOL_GROUPS

D_FF = 4 * D_MODEL
PLE_DIM = 256
ALPHA = (2 * DEPTH) ** 0.25
BETA = (8 * DEPTH) ** (-0.25)
LN_EPS = 1e-5

kernel_name = "hybrid_rglru_pool_deepnorm_trunk"


def layer_norm(x, g, b):
    xf = x.astype(jnp.float32)
    mu = jnp.mean(xf, axis=-1, keepdims=True)
    var = jnp.mean(jnp.square(xf - mu), axis=-1, keepdims=True)
    y = (xf - mu) * lax.rsqrt(var + LN_EPS)
    return (y * g.astype(jnp.float32) + b.astype(jnp.float32)).astype(x.dtype)


def causal_depthwise_conv(u, w, b):
    s = u.shape[1]
    up = jnp.pad(u, ((0, 0), (CONV_WIDTH - 1, 0), (0, 0)))
    out = b
    for k in range(CONV_WIDTH):
        out = out + up[:, k:k + s] * w[k]
    return out


def _lin_rec_combine(left, right):
    a1, b1 = left
    a2, b2 = right
    return a1 * a2, a2 * b1 + b2


def rg_lru(u, wa, ba, wx, bx, lam):
    bsz, s, _ = u.shape
    uh = u.reshape(bsz, s, LRU_HEADS, LRU_BW)
    r = jax.nn.sigmoid(jnp.einsum('bshi,hij->bshj', uh, wa).reshape(bsz, s, D_RNN) + ba)
    ig = jax.nn.sigmoid(jnp.einsum('bshi,hij->bshj', uh, wx).reshape(bsz, s, D_RNN) + bx)
    log_a = -LRU_C * r.astype(jnp.float32) * jax.nn.softplus(-lam.astype(jnp.float32))
    a = jnp.exp(log_a)
    mult = jnp.sqrt(-jnp.expm1(2.0 * log_a))
    mult = mult.at[:, 0].set(1.0)
    bterm = mult * (ig * u).astype(jnp.float32)
    _, h = lax.associative_scan(_lin_rec_combine, (a, bterm), axis=1)
    return h.astype(u.dtype)


def recurrent_mixer(x, w_in, conv_w, conv_b, wa, ba, wx, bx, lam, w_out):
    proj = x @ w_in
    u, y = proj[..., :D_RNN], proj[..., D_RNN:]
    u = causal_depthwise_conv(u, conv_w, conv_b)
    h = rg_lru(u, wa, ba, wx, bx, lam)
    return (h * jax.nn.gelu(y)) @ w_out


def pooling_mixer(x, w_in, w_grp, b_grp, scale, w_out):
    u = x @ w_in
    s = u.shape[1]
    pos = jnp.arange(s, dtype=jnp.int32)
    outs = []
    for g, w in enumerate(POOL_WINDOWS):
        ug = u[..., g * POOL_GW:(g + 1) * POOL_GW].astype(jnp.float32)
        cs = jnp.cumsum(ug, axis=1)
        cs_prev = jnp.pad(cs, ((0, 0), (w, 0), (0, 0)))[:, :s]
        cnt = jnp.minimum(pos + 1, w).astype(jnp.float32)[None, :, None]
        outs.append((cs - cs_prev) / cnt - ug)
    z = jnp.stack(outs, axis=2).astype(u.dtype)
    z = jnp.einsum('bsgi,gij->bsgj', z, w_grp).reshape(u.shape) + b_grp
    return (z * scale) @ w_out


def sq_relu_mlp(x, w1, w2):
    h = jax.nn.relu(x @ w1)
    return (h * h) @ w2


def setup_inputs(seed: int = 0) -> dict:
    key = jax.random.key(seed)
    ks = jax.random.split(key, 26)
    f32 = jnp.float32

    def nrm(k, shape, scale):
        return jax.random.normal(k, shape, f32) * scale

    a_c = jax.random.uniform(ks[8], (N_A, D_RNN), f32, minval=0.9, maxval=0.999)
    a0 = a_c ** (1.0 / LRU_C)
    lam = jnp.log(a0) - jnp.log1p(-a0)
    return {
        "x": nrm(ks[0], (BATCH, SEQ, D_MODEL), 1.0),
        "p": nrm(ks[1], (DEPTH, BATCH, SEQ, PLE_DIM), 1.0),
        "lru_w_in": nrm(ks[2], (N_A, D_MODEL, 2 * D_RNN), D_MODEL ** -0.5),
        "lru_conv_w": nrm(ks[3], (N_A, CONV_WIDTH, D_RNN), CONV_WIDTH ** -0.5),
        "lru_conv_b": nrm(ks[4], (N_A, D_RNN), 0.01),
        "lru_wa": nrm(ks[5], (N_A, LRU_HEADS, LRU_BW, LRU_BW), LRU_BW ** -0.5),
        "lru_ba": nrm(ks[6], (N_A, D_RNN), 0.01),
        "lru_wx": nrm(ks[7], (N_A, LRU_HEADS, LRU_BW, LRU_BW), LRU_BW ** -0.5),
        "lru_bx": nrm(ks[9], (N_A, D_RNN), 0.01),
        "lru_lambda": lam,
        "lru_w_out": nrm(ks[10], (N_A, D_RNN, D_MODEL), BETA * D_RNN ** -0.5),
        "pool_w_in": nrm(ks[11], (N_B, D_MODEL, D_POOL), D_MODEL ** -0.5),
        "pool_w_grp": nrm(ks[12], (N_B, POOL_GROUPS, POOL_GW, POOL_GW), POOL_GW ** -0.5),
        "pool_b_grp": nrm(ks[13], (N_B, D_POOL), 0.01),
        "pool_scale": 1.0 + nrm(ks[14], (N_B, D_POOL), 0.1),
        "pool_w_out": nrm(ks[15], (N_B, D_POOL, D_MODEL), BETA * D_POOL ** -0.5),
        "ln_mix_g": 1.0 + nrm(ks[16], (DEPTH, D_MODEL), 0.05),
        "ln_mix_b": nrm(ks[17], (DEPTH, D_MODEL), 0.01),
        "mlp_w1": nrm(ks[18], (DEPTH, D_MODEL, D_FF), D_MODEL ** -0.5),
        "mlp_w2": nrm(ks[19], (DEPTH, D_FF, D_MODEL), BETA * D_FF ** -0.5),
        "ln_mlp_g": 1.0 + nrm(ks[20], (DEPTH, D_MODEL), 0.05),
        "ln_mlp_b": nrm(ks[21], (DEPTH, D_MODEL), 0.01),
        "ple_w": nrm(ks[22], (DEPTH, PLE_DIM, D_MODEL), PLE_DIM ** -0.5),
        "ple_gate_w": nrm(ks[23], (DEPTH, D_MODEL, D_MODEL), D_MODEL ** -0.5),
        "ple_gate_b": nrm(ks[24], (DEPTH, D_MODEL), 0.01),
    }


def reference(x, p, lru_w_in, lru_conv_w, lru_conv_b, lru_wa, lru_ba, lru_wx, lru_bx,
              lru_lambda, lru_w_out, pool_w_in, pool_w_grp, pool_b_grp, pool_scale,
              pool_w_out, ln_mix_g, ln_mix_b, mlp_w1, mlp_w2, ln_mlp_g, ln_mlp_b,
              ple_w, ple_gate_w, ple_gate_b):
    for i in range(DEPTH):
        slot = i // N_MIXERS
        if i % N_MIXERS == 0:
            m = recurrent_mixer(x, lru_w_in[slot], lru_conv_w[slot], lru_conv_b[slot],
                                lru_wa[slot], lru_ba[slot], lru_wx[slot], lru_bx[slot],
                                lru_lambda[slot], lru_w_out[slot])
        else:
            m = pooling_mixer(x, pool_w_in[slot], pool_w_grp[slot], pool_b_grp[slot],
                              pool_scale[slot], pool_w_out[slot])
        x = layer_norm(ALPHA * x + m, ln_mix_g[i], ln_mix_b[i])
        x = layer_norm(ALPHA * x + sq_relu_mlp(x, mlp_w1[i], mlp_w2[i]), ln_mlp_g[i], ln_mlp_b[i])
        gate = jax.nn.sigmoid(x @ ple_gate_w[i] + ple_gate_b[i])
        x = x + (p[i] @ ple_w[i]) * gate
    return x
```

```cpp
#include <hip/hip_runtime.h>
#include <hip/hip_cooperative_groups.h>
#include <cstdio>
namespace cg = cooperative_groups;

#ifndef ONE_LAUNCH
#define ONE_LAUNCH 1
#endif

#define LAS __attribute__((address_space(3)))
typedef unsigned short bf16_t;
typedef short bf16x8 __attribute__((ext_vector_type(8)));
typedef float f32x4 __attribute__((ext_vector_type(4)));
typedef unsigned u32x4 __attribute__((ext_vector_type(4)));
typedef unsigned u32x2 __attribute__((ext_vector_type(2)));

constexpr int M_TOK = 32768, DM = 1024, DR = 1536, DFF = 4096, SEQ = 4096, PLE = 256;
constexpr float ALPHA_F = 1.681792830507429f;
constexpr float LN_EPS_F = 1e-5f;
constexpr int NTHR = 512;
constexpr int LDS_BYTES = 131072;

constexpr size_t MiB = 1024ull * 1024ull;
constexpr size_t OFF_WMIX = 0;
constexpr size_t OFF_WMLP = 12 * MiB;
constexpr size_t OFF_XB   = 32 * MiB;
constexpr size_t OFF_REG  = 96 * MiB;
constexpr size_t OFF_B1   = OFF_REG;
constexpr size_t OFF_B2   = OFF_REG + 96 * MiB;
constexpr size_t OFF_B3   = OFF_REG + 192 * MiB;
constexpr size_t OFF_B4   = OFF_REG + 288 * MiB;
constexpr size_t OFF_PB   = OFF_REG + 256 * MiB;
constexpr size_t OFF_SUMA = 480 * MiB;
constexpr size_t OFF_SUMH = 483 * MiB;
constexpr size_t OFF_NSP  = 486 * MiB;
constexpr size_t WA_IN = 0, WA_GT = 3145728, WA_OUT = 3932160;
constexpr size_t WB_IN = 0, WB_GT = 1048576, WB_OUT = 1310720;
constexpr size_t WM_W1 = 0, WM_W2 = 4194304, WM_PLE = 8388608, WM_PG = 8650752;

struct Args { const float* in[25]; float* out; unsigned char* ws; int ph_lo, ph_hi; };

__device__ __forceinline__ int tid_() { int t = threadIdx.x; asm volatile("" : "+v"(t)); return t; }
__device__ __forceinline__ int bid_() { int t = blockIdx.x; asm volatile("" : "+s"(t)); return t; }
__device__ __forceinline__ int gdim_() { int t = gridDim.x; asm volatile("" : "+s"(t)); return t; }
__device__ __forceinline__ unsigned cvt_pk_bf16(float lo, float hi) { unsigned r; asm volatile("v_cvt_pk_bf16_f32 %0, %1, %2" : "=v"(r) : "v"(lo), "v"(hi)); return r; }
__device__ __forceinline__ float bf_lo(unsigned w) { return __uint_as_float(w << 16); }
__device__ __forceinline__ float bf_hi(unsigned w) { return __uint_as_float(w & 0xffff0000u); }
__device__ __forceinline__ float fast_exp(float x) { return __builtin_amdgcn_exp2f(x * 1.4426950408889634f); }
__device__ __forceinline__ float sigmoidf_(float x) { return __builtin_amdgcn_rcpf(1.0f + __builtin_amdgcn_exp2f(-1.4426950408889634f * x)); }
__device__ __forceinline__ float gelu_tanh(float v) { const float in = v + 0.044715f * v * v * v; return v * __builtin_amdgcn_rcpf(1.0f + __builtin_amdgcn_exp2f(-2.302208198f * in)); }
__device__ __forceinline__ void unpack8(const u32x4 w, float (&f)[8]) {
    f[0] = bf_lo(w.x); f[1] = bf_hi(w.x); f[2] = bf_lo(w.y); f[3] = bf_hi(w.y); f[4] = bf_lo(w.z); f[5] = bf_hi(w.z); f[6] = bf_lo(w.w); f[7] = bf_hi(w.w); }
__device__ __forceinline__ u32x4 pack8(const float (&f)[8]) { u32x4 w; w.x = cvt_pk_bf16(f[0], f[1]); w.y = cvt_pk_bf16(f[2], f[3]); w.z = cvt_pk_bf16(f[4], f[5]); w.w = cvt_pk_bf16(f[6], f[7]); return w; }

namespace pg8 {
constexpr int BM = 256, BK = 64, HALF = 128, HTB = HALF * BK * 2, STAGE_BYTES = 8 * HTB, NXCD = 8, WGM = 8;
__device__ __forceinline__ int lds_byte(int r, int c) { const int st = (r >> 4) * 2 + (c >> 5), rr = r & 15, cc = c & 31, ob = rr * 64 + cc * 2; return st * 1024 + (ob ^ (((ob >> 9) & 1) << 5)); }
__device__ __forceinline__ void stage_rc(int b, int& R, int& C) { const int st = b / 1024, sb = b % 1024, swz = sb ^ (((sb >> 9) & 1) << 5); R = (st >> 1) * 16 + swz / 64; C = (st & 1) * 32 + (swz % 64) / 2; }
__device__ __forceinline__ int perm32(int rho) { const int n = rho >> 4, i = rho & 15; return 8 * (i >> 2) + 4 * n + (i & 3); }

struct Unit { int pm, pn; };
struct Gemm { const bf16_t* A; const bf16_t* Bt; int M, N, K, lda, a_shift, a_step; };

struct StaticOrder {
    int nM, nN, nwg, G, c;
    __device__ void init(int M, int N, int G_, int c_) { nM = M / BM; nN = N / BM; nwg = nM * nN; G = G_; c = c_; }
    __device__ bool next(int i, Unit& u) const {
        const long L = (long)i * G + c; if (L >= nwg) return false;
        int wgid = (int)L; { const int q = nwg / NXCD, r = nwg % NXCD, xcd = wgid % NXCD, off = wgid / NXCD; wgid = (xcd < r ? xcd * (q + 1) : r * (q + 1) + (xcd - r) * q) + off; }
        const int nig = WGM * nN, gid = wgid / nig, fm = gid * WGM, gsz = (nM - fm) < WGM ? (nM - fm) : WGM;
        u.pm = fm + ((wgid % nig) % gsz); u.pn = (wgid % nig) / gsz; return true;
    }
};

template <class Epi>
__device__ __forceinline__ void gemm_phase(LAS unsigned char* lds, const Gemm g, const StaticOrder& S, const Epi& E) {
    const int tid = tid_(), wid = __builtin_amdgcn_readfirstlane(tid >> 6), lane = tid & 63, wr = wid >> 2, wc = wid & 3, fr = lane & 15, fq = lane >> 4;
    const int K = g.K, nt = K / BK, lda = g.lda;
    unsigned voffA[2], voffB[2];
#pragma unroll
    for (int i = 0; i < 2; ++i) { int R, C; stage_rc(tid * 16 + i * 8192, R, C); const int Rb = (R & ~31) + perm32(R & 31);
        voffA[i] = (unsigned)(R * lda + C) * 2u; voffB[i] = (unsigned)(Rb * K + C) * 2u; }
    const size_t kstep = (size_t)(BK * 2);
    const size_t hstepA = (size_t)HALF * lda * 2, hstepB = (size_t)HALF * K * 2;
    const unsigned ldsw = (unsigned)wid * 1024u;
    const int aoff = lds_byte(wr * 64 + fr, fq * 8), boff = lds_byte(wc * 32 + fr, fq * 8);
#define PG8_SA(b, h) (((b) * 2 + (h)) * HTB)
#define PG8_SB(b, h) ((4 + (b) * 2 + (h)) * HTB)
#define PG8_STAGE(bufoff, gbase, voff) do { _Pragma("unroll") for (int _i = 0; _i < 2; ++_i) \
        __builtin_amdgcn_global_load_lds((const unsigned*)((const char*)(gbase) + (voff)[_i]), (LAS unsigned*)(lds + (bufoff) + ldsw + _i * 8192), 16, 0, 0); } while (0)
#define PG8_LDA(dst, b, h) do { _Pragma("unroll") for (int m = 0; m < 4; ++m) _Pragma("unroll") for (int k = 0; k < 2; ++k) dst[m][k] = *(const LAS bf16x8*)(lds + PG8_SA(b, h) + aoff + m * 2048 + k * 1024); } while (0)
#define PG8_LDB(dst, b, h) do { _Pragma("unroll") for (int n = 0; n < 2; ++n) _Pragma("unroll") for (int k = 0; k < 2; ++k) dst[n][k] = *(const LAS bf16x8*)(lds + PG8_SB(b, h) + boff + n * 2048 + k * 1024); } while (0)
#define PG8_MMA(ai, bj, At, Bt) do { __builtin_amdgcn_s_setprio(1); _Pragma("unroll") for (int m = 0; m < 4; ++m) _Pragma("unroll") for (int n = 0; n < 2; ++n) _Pragma("unroll") for (int k = 0; k < 2; ++k) \
        acc[ai][bj][m][n] = __builtin_amdgcn_mfma_f32_16x16x32_bf16(Bt[n][k], At[m][k], acc[ai][bj][m][n], 0, 0, 0); __builtin_amdgcn_s_setprio(0); } while (0)
#define PG8_WAIT_V(n) asm volatile("s_waitcnt vmcnt(" #n ")" ::: "memory")
#define PG8_WAIT_L(n) asm volatile("s_waitcnt lgkmcnt(" #n ")" ::: "memory")
#define PG8_BAR __builtin_amdgcn_s_barrier()
#define PG8_SCHED __builtin_amdgcn_sched_barrier(0)
#define PG8_UNITA(u) ((const char*)g.A + (size_t)(u).pm * 2 * hstepA + (size_t)(((u).pn >> g.a_shift) * g.a_step) * 2)
#define PG8_UNITB(u) ((const char*)g.Bt + (size_t)(u).pn * 2 * hstepB)
    Unit cur, nxt; int ui = 0;
    if (!S.next(0, cur)) return;
    float zf = 0.f; asm volatile("" : "+v"(zf));
    f32x4 acc[2][2][4][2];
#pragma unroll
    for (int a = 0; a < 2; ++a)
#pragma unroll
        for (int b = 0; b < 2; ++b)
#pragma unroll
            for (int m = 0; m < 4; ++m)
#pragma unroll
                for (int n = 0; n < 2; ++n) acc[a][b][m][n] = (f32x4){zf, zf, zf, zf};
    bf16x8 At[4][2], B0[2][2], B1[2][2];
    const char* cA = PG8_UNITA(cur); const char* cB = PG8_UNITB(cur);
    PG8_STAGE(PG8_SB(0, 0), cB, voffB); PG8_STAGE(PG8_SA(0, 0), cA, voffA); PG8_STAGE(PG8_SB(0, 1), cB + hstepB, voffB); PG8_STAGE(PG8_SA(0, 1), cA + hstepA, voffA);
    if (wr == 1) PG8_BAR;
    PG8_WAIT_V(4); PG8_BAR;
    PG8_STAGE(PG8_SB(1, 0), cB + kstep, voffB); PG8_STAGE(PG8_SA(1, 0), cA + kstep, voffA); PG8_STAGE(PG8_SB(1, 1), cB + hstepB + kstep, voffB);
    PG8_WAIT_V(6); PG8_BAR;
    for (;;) {
        const bool has_next = S.next(ui + 1, nxt);
        const char* nA = has_next ? PG8_UNITA(nxt) : cA; const char* nB = has_next ? PG8_UNITB(nxt) : cB;
        for (int t = 0; t < nt; t += 2) {
            const bool last = (t == nt - 2);
            const char* a1 = cA + (size_t)(t + 1) * kstep;
            const char* a2 = last ? nA : cA + (size_t)(t + 2) * kstep; const char* b2 = last ? nB : cB + (size_t)(t + 2) * kstep;
            const char* a3 = a2 + kstep; const char* b3 = b2 + kstep;
            PG8_LDB(B0, 0, 0); PG8_SCHED; PG8_LDA(At, 0, 0); PG8_STAGE(PG8_SA(1, 1), a1 + hstepA, voffA);
            PG8_WAIT_L(8); PG8_BAR; PG8_WAIT_L(0); PG8_MMA(0, 0, At, B0); PG8_BAR; PG8_SCHED;
            PG8_LDB(B1, 0, 1); PG8_STAGE(PG8_SB(0, 0), b2, voffB);
            PG8_BAR; PG8_WAIT_L(0); PG8_MMA(0, 1, At, B1); PG8_BAR;
            PG8_LDA(At, 0, 1); PG8_STAGE(PG8_SA(0, 0), a2, voffA);
            PG8_BAR; PG8_WAIT_L(0); PG8_MMA(1, 0, At, B0); PG8_BAR; PG8_SCHED;
            PG8_STAGE(PG8_SB(0, 1), b2 + hstepB, voffB);
            PG8_WAIT_V(6); PG8_BAR; PG8_MMA(1, 1, At, B1); PG8_BAR;
            PG8_LDB(B0, 1, 0); PG8_SCHED; PG8_LDA(At, 1, 0); PG8_STAGE(PG8_SA(0, 1), a2 + hstepA, voffA);
            PG8_WAIT_L(8); PG8_BAR; PG8_WAIT_L(0); PG8_MMA(0, 0, At, B0); PG8_BAR; PG8_SCHED;
            PG8_LDB(B1, 1, 1); PG8_STAGE(PG8_SB(1, 0), b3, voffB);
            PG8_BAR; PG8_WAIT_L(0); PG8_MMA(0, 1, At, B1); PG8_BAR;
            PG8_LDA(At, 1, 1); PG8_STAGE(PG8_SA(1, 0), a3, voffA);
            PG8_BAR; PG8_WAIT_L(0); PG8_MMA(1, 0, At, B0); PG8_BAR; PG8_SCHED;
            PG8_STAGE(PG8_SB(1, 1), b3 + hstepB, voffB);
            PG8_WAIT_V(6); PG8_BAR; PG8_MMA(1, 1, At, B1); PG8_BAR;
        }
        E(acc, cur, wr, wc, fr, fq);
        if (!has_next) break;
#pragma unroll
        for (int a = 0; a < 2; ++a)
#pragma unroll
            for (int b = 0; b < 2; ++b)
#pragma unroll
                for (int m = 0; m < 4; ++m)
#pragma unroll
                    for (int n = 0; n < 2; ++n) acc[a][b][m][n] = (f32x4){zf, zf, zf, zf};
        cur = nxt; cA = nA; cB = nB; ++ui;
    }
    PG8_WAIT_V(0);
    if (wr == 0) PG8_BAR;
    PG8_BAR;
#undef PG8_SA
#undef PG8_SB
#undef PG8_STAGE
#undef PG8_LDA
#undef PG8_LDB
#undef PG8_MMA
#undef PG8_WAIT_V
#undef PG8_WAIT_L
#undef PG8_BAR
#undef PG8_SCHED
#undef PG8_UNITA
#undef PG8_UNITB
}
}

typedef f32x4 AccT[2][2][4][2];

struct EpiG1 {
    bf16_t* U; int ldu; bf16_t* Y; int ldy; int nsplit;
    __device__ __forceinline__ void operator()(const AccT& acc, const pg8::Unit& u, int wr, int wc, int fr, int fq) const {
        const int row0 = u.pm * 256 + wr * 64 + fr;
        bf16_t* base; int ld, colt; bool act;
        if (u.pn < nsplit) { base = U; ld = ldu; colt = u.pn * 256; act = false; } else { base = Y; ld = ldy; colt = (u.pn - nsplit) * 256; act = true; }
        const int col0 = colt + wc * 32 + 8 * fq;
#pragma unroll
        for (int ai = 0; ai < 2; ++ai)
#pragma unroll
            for (int m = 0; m < 4; ++m) { bf16_t* rowp = base + (size_t)(row0 + ai * 128 + m * 16) * ld + col0;
#pragma unroll
                for (int bj = 0; bj < 2; ++bj) { f32x4 v0 = acc[ai][bj][m][0], v1 = acc[ai][bj][m][1];
                    if (act) {
#pragma unroll
                        for (int j = 0; j < 4; ++j) { v0[j] = gelu_tanh(v0[j]); v1[j] = gelu_tanh(v1[j]); } }
                    u32x4 w; w.x = cvt_pk_bf16(v0[0], v0[1]); w.y = cvt_pk_bf16(v0[2], v0[3]); w.z = cvt_pk_bf16(v1[0], v1[1]); w.w = cvt_pk_bf16(v1[2], v1[3]);
                    *(u32x4*)(rowp + bj * 128) = w; } }
    }
};
template <int ACT> struct EpiStore {
    bf16_t* O; int ldo; const float* bias; const float* scale;
    __device__ __forceinline__ void operator()(const AccT& acc, const pg8::Unit& u, int wr, int wc, int fr, int fq) const {
        const int row0 = u.pm * 256 + wr * 64 + fr, col0 = u.pn * 256 + wc * 32 + 8 * fq;
#pragma unroll
        for (int bj = 0; bj < 2; ++bj) {
            f32x4 bv[2], sv[2];
            if (ACT == 2) {
#pragma unroll
                for (int n = 0; n < 2; ++n) { bv[n] = *(const f32x4*)(bias + col0 + bj * 128 + 4 * n); sv[n] = *(const f32x4*)(scale + col0 + bj * 128 + 4 * n); } }
#pragma unroll
            for (int ai = 0; ai < 2; ++ai)
#pragma unroll
                for (int m = 0; m < 4; ++m) { bf16_t* rowp = O + (size_t)(row0 + ai * 128 + m * 16) * ldo + col0;
                    f32x4 v0 = acc[ai][bj][m][0], v1 = acc[ai][bj][m][1];
                    if (ACT == 1) {
#pragma unroll
                        for (int j = 0; j < 4; ++j) { const float a = fmaxf(v0[j], 0.f), b = fmaxf(v1[j], 0.f); v0[j] = a * a; v1[j] = b * b; } }
                    if (ACT == 2) { v0 = (v0 + bv[0]) * sv[0]; v1 = (v1 + bv[1]) * sv[1]; }
                    u32x4 w; w.x = cvt_pk_bf16(v0[0], v0[1]); w.y = cvt_pk_bf16(v0[2], v0[3]); w.z = cvt_pk_bf16(v1[0], v1[1]); w.w = cvt_pk_bf16(v1[2], v1[3]);
                    *(u32x4*)(rowp + bj * 128) = w; }
            __builtin_amdgcn_sched_barrier(0);
        }
    }
};
struct EpiResid {
    const float* xres; float* out;
    __device__ __forceinline__ void operator()(const AccT& acc, const pg8::Unit& u, int wr, int wc, int fr, int fq) const {
        const int row0 = u.pm * 256 + wr * 64 + fr, col0 = u.pn * 256 + wc * 32 + 8 * fq;
#pragma unroll
        for (int ai = 0; ai < 2; ++ai)
#pragma unroll
            for (int m = 0; m < 4; ++m) { const size_t ro = (size_t)(row0 + ai * 128 + m * 16) * DM + col0;
#pragma unroll
                for (int bj = 0; bj < 2; ++bj)
#pragma unroll
                    for (int n = 0; n < 2; ++n) { const f32x4 xv = *(const f32x4*)(xres + ro + bj * 128 + 4 * n);
                        *(f32x4*)(out + ro + bj * 128 + 4 * n) = acc[ai][bj][m][n] + ALPHA_F * xv; } }
    }
};
struct EpiGates {
    bf16_t* LA; bf16_t* BB; const bf16_t* UC; const float* ba; const float* bx; const float* nsp;
    __device__ __forceinline__ void operator()(const AccT& acc, const pg8::Unit& u, int wr, int wc, int fr, int fq) const {
        const int row0 = u.pm * 256 + wr * 64 + fr, ch0 = u.pn * 128 + wc * 32 + 8 * fq;
#pragma unroll
        for (int n = 0; n < 2; ++n) {
            const f32x4 bav = *(const f32x4*)(ba + ch0 + 4 * n), bxv = *(const f32x4*)(bx + ch0 + 4 * n), nsv = *(const f32x4*)(nsp + ch0 + 4 * n);
#pragma unroll
            for (int ai = 0; ai < 2; ++ai)
#pragma unroll
                for (int m = 0; m < 4; ++m) { const int row = row0 + ai * 128 + m * 16; const size_t ro = (size_t)row * DR + ch0 + 4 * n;
                    const bool t0 = (row & (SEQ - 1)) == 0;
                    const u32x2 ucw = *(const u32x2*)(UC + ro);
                    const float uc[4] = {bf_lo(ucw.x), bf_hi(ucw.x), bf_lo(ucw.y), bf_hi(ucw.y)};
                    float lo[4], bo[4];
#pragma unroll
                    for (int j = 0; j < 4; ++j) {
                        const float r = sigmoidf_(acc[ai][0][m][n][j] + bav[j]);
                        const float ig = sigmoidf_(acc[ai][1][m][n][j] + bxv[j]);
                        const float la = nsv[j] * r;
                        const float a2 = __builtin_amdgcn_exp2f(la * 2.8853900817779268f);
                        const float mult = t0 ? 1.0f : __builtin_amdgcn_sqrtf(fmaxf(1.0f - a2, 0.f));
                        lo[j] = la; bo[j] = mult * ig * uc[j]; }
                    u32x2 wl, wb; wl.x = cvt_pk_bf16(lo[0], lo[1]); wl.y = cvt_pk_bf16(lo[2], lo[3]); wb.x = cvt_pk_bf16(bo[0], bo[1]); wb.y = cvt_pk_bf16(bo[2], bo[3]);
                    *(u32x2*)(LA + ro) = wl; *(u32x2*)(BB + ro) = wb; }
            __builtin_amdgcn_sched_barrier(0);
        }
    }
};
struct EpiPle {
    float* X; const bf16_t* T; const float* bg; bf16_t* XIN;
    __device__ __forceinline__ void operator()(const AccT& acc, const pg8::Unit& u, int wr, int wc, int fr, int fq) const {
        const int row0 = u.pm * 256 + wr * 64 + fr, col0 = u.pn * 256 + wc * 32 + 8 * fq;
        f32x4 bv[2][2];
#pragma unroll
        for (int bj = 0; bj < 2; ++bj)
#pragma unroll
            for (int n = 0; n < 2; ++n) bv[bj][n] = *(const f32x4*)(bg + col0 + bj * 128 + 4 * n);
#pragma unroll
        for (int ai = 0; ai < 2; ++ai)
#pragma unroll
            for (int m = 0; m < 4; ++m) { const size_t ro = (size_t)(row0 + ai * 128 + m * 16) * DM + col0;
#pragma unroll
                for (int bj = 0; bj < 2; ++bj) {
                    const u32x4 tw = *(const u32x4*)(T + ro + bj * 128); float tv[8]; unpack8(tw, tv);
                    const f32x4 x0 = *(const f32x4*)(X + ro + bj * 128), x1 = *(const f32x4*)(X + ro + bj * 128 + 4);
                    f32x4 o0, o1;
#pragma unroll
                    for (int j = 0; j < 4; ++j) { o0[j] = x0[j] + tv[j] * sigmoidf_(acc[ai][bj][m][0][j] + bv[bj][0][j]); o1[j] = x1[j] + tv[4 + j] * sigmoidf_(acc[ai][bj][m][1][j] + bv[bj][1][j]); }
                    *(f32x4*)(X + ro + bj * 128) = o0; *(f32x4*)(X + ro + bj * 128 + 4) = o1;
                    u32x4 w; w.x = cvt_pk_bf16(o0[0], o0[1]); w.y = cvt_pk_bf16(o0[2], o0[3]); w.z = cvt_pk_bf16(o1[0], o1[1]); w.w = cvt_pk_bf16(o1[2], o1[3]);
                    *(u32x4*)(XIN + ro + bj * 128) = w; } }
    }
};

__device__ __forceinline__ void tc_mat(LAS unsigned char* lds, const float* src, int K, int N, int ld_src, bf16_t* dst, int ld_dst, int& base) {
    LAS float* s = (LAS float*)lds;
    const int G = gdim_(), tid = tid_();
    const int tn = N >> 6, ntiles = (K >> 6) * tn;
    int t0 = ((int)bid_() - base) % G; if (t0 < 0) t0 += G;
    for (int t = t0; t < ntiles; t += G) {
        const int k0 = (t / tn) << 6, n0 = (t % tn) << 6;
#pragma unroll
        for (int j = 0; j < 8; ++j) { const int idx = j * NTHR + tid, kk = idx >> 6, nn = idx & 63; s[kk * 65 + nn] = src[(size_t)(k0 + kk) * ld_src + n0 + nn]; }
        __syncthreads();
        { const int n = tid >> 3, kg = tid & 7; float v[8];
#pragma unroll
          for (int i = 0; i < 8; ++i) v[i] = s[(kg * 8 + i) * 65 + n];
          *(u32x4*)(dst + (size_t)(n0 + n) * ld_dst + k0 + kg * 8) = pack8(v); }
        __syncthreads();
    }
    base += ntiles;
}

typedef const float* cfp;
typedef const __attribute__((address_space(4))) unsigned char* kptr_t;
__device__ __forceinline__ const float* kin(kptr_t kp, int i) { return *(const __attribute__((address_space(4))) cfp*)(kp + 8 * i); }
__device__ __forceinline__ float* kout(kptr_t kp) { return *(float* const __attribute__((address_space(4)))*)(kp + 200); }
__device__ __forceinline__ unsigned char* kws(kptr_t kp) { return *(unsigned char* const __attribute__((address_space(4)))*)(kp + 208); }

__device__ __forceinline__ void conv_wmix(LAS unsigned char* lds, kptr_t kp, int layer, bf16_t* wmix) {
    int base = 0; const int slot = layer >> 1;
    if (!(layer & 1)) {
        tc_mat(lds, kin(kp, 2) + (size_t)slot * 1024 * 3072, 1024, 3072, 3072, wmix + WA_IN, 1024, base);
        const float* wa = kin(kp, 5); const float* wx = kin(kp, 7);
#pragma unroll 1
        for (int h = 0; h < 12; ++h) {
            tc_mat(lds, wa + (size_t)(slot * 12 + h) * 16384, 128, 128, 128, wmix + WA_GT + (size_t)(h * 256) * 256 + (h & 1) * 128, 256, base);
            tc_mat(lds, wx + (size_t)(slot * 12 + h) * 16384, 128, 128, 128, wmix + WA_GT + (size_t)(h * 256 + 128) * 256 + (h & 1) * 128, 256, base);
        }
        tc_mat(lds, kin(kp, 10) + (size_t)slot * 1536 * 1024, 1536, 1024, 1024, wmix + WA_OUT, 1536, base);
        unsigned zu = 0u; asm volatile("" : "+v"(zu));
        for (int it = bid_() * NTHR + tid_(); it < 12 * 256 * 16; it += gdim_() * NTHR) {
            const int seg = it & 15, rr = it >> 4, h = rr >> 8;
            *(u32x4*)(wmix + WA_GT + (size_t)rr * 256 + ((h & 1) ^ 1) * 128 + seg * 8) = (u32x4){zu, zu, zu, zu};
        }
    } else {
        tc_mat(lds, kin(kp, 11) + (size_t)slot * 1024 * 1024, 1024, 1024, 1024, wmix + WB_IN, 1024, base);
        const float* wg = kin(kp, 12);
#pragma unroll 1
        for (int g = 0; g < 4; ++g) tc_mat(lds, wg + (size_t)(slot * 4 + g) * 65536, 256, 256, 256, wmix + WB_GT + (size_t)g * 65536, 256, base);
        tc_mat(lds, kin(kp, 15) + (size_t)slot * 1024 * 1024, 1024, 1024, 1024, wmix + WB_OUT, 1024, base);
    }
}
__device__ __forceinline__ void conv_wmlp(LAS unsigned char* lds, kptr_t kp, int layer, bf16_t* wmlp) {
    int base = 0;
    tc_mat(lds, kin(kp, 18) + (size_t)layer * 1024 * 4096, 1024, 4096, 4096, wmlp + WM_W1, 1024, base);
    tc_mat(lds, kin(kp, 19) + (size_t)layer * 4096 * 1024, 4096, 1024, 1024, wmlp + WM_W2, 4096, base);
    tc_mat(lds, kin(kp, 22) + (size_t)layer * 256 * 1024, 256, 1024, 1024, wmlp + WM_PLE, 256, base);
    tc_mat(lds, kin(kp, 23) + (size_t)layer * 1024 * 1024, 1024, 1024, 1024, wmlp + WM_PG, 1024, base);
}
__device__ __forceinline__ void cvt_rows(const float* src, bf16_t* dst, size_t n8) {
    const size_t nthr = (size_t)gdim_() * NTHR;
    for (size_t i = (size_t)bid_() * NTHR + tid_(); i < n8; i += nthr) {
        const f32x4 a = *(const f32x4*)(src + i * 8), b = *(const f32x4*)(src + i * 8 + 4);
        u32x4 w; w.x = cvt_pk_bf16(a[0], a[1]); w.y = cvt_pk_bf16(a[2], a[3]); w.z = cvt_pk_bf16(b[0], b[1]); w.w = cvt_pk_bf16(b[2], b[3]);
        *(u32x4*)(dst + i * 8) = w;
    }
}
__device__ __forceinline__ void ln_rows(float* X, bf16_t* XB, const float* gam, const float* bet) {
    const int tid = tid_(), lane = tid & 63, wave = tid >> 6;
    f32x4 gv[4], bv[4];
#pragma unroll
    for (int k = 0; k < 4; ++k) { gv[k] = *(const f32x4*)(gam + k * 256 + lane * 4); bv[k] = *(const f32x4*)(bet + k * 256 + lane * 4); }
    for (int row = bid_() * 8 + wave; row < M_TOK; row += gdim_() * 8) {
        float* xr = X + (size_t)row * DM + lane * 4;
        f32x4 v[4];
#pragma unroll
        for (int k = 0; k < 4; ++k) v[k] = *(const f32x4*)(xr + k * 256);
        float s = 0.f;
#pragma unroll
        for (int k = 0; k < 4; ++k) s += (v[k][0] + v[k][1]) + (v[k][2] + v[k][3]);
#pragma unroll
        for (int o = 32; o >= 1; o >>= 1) s += __int_as_float(__builtin_amdgcn_ds_bpermute((lane ^ o) << 2, __float_as_int(s)));
        const float mean = s * (1.0f / 1024.0f);
        float q = 0.f;
#pragma unroll
        for (int k = 0; k < 4; ++k) { const f32x4 d = v[k] - mean; q += (d[0] * d[0] + d[1] * d[1]) + (d[2] * d[2] + d[3] * d[3]); }
#pragma unroll
        for (int o = 32; o >= 1; o >>= 1) q += __int_as_float(__builtin_amdgcn_ds_bpermute((lane ^ o) << 2, __float_as_int(q)));
        const float rstd = __builtin_amdgcn_rsqf(q * (1.0f / 1024.0f) + LN_EPS_F);
        bf16_t* xb = XB + (size_t)row * DM + lane * 4;
#pragma unroll
        for (int k = 0; k < 4; ++k) { const f32x4 y = (v[k] - mean) * rstd * gv[k] + bv[k];
            *(f32x4*)(xr + k * 256) = y;
            u32x2 w; w.x = cvt_pk_bf16(y[0], y[1]); w.y = cvt_pk_bf16(y[2], y[3]); *(u32x2*)(xb + k * 256) = w; }
    }
}
__device__ __forceinline__ void conv_phase(const bf16_t* U, bf16_t* UC, const float* cw, const float* cb) {
    const int nthr = gdim_() * NTHR;
    for (int item = bid_() * NTHR + tid_(); item < (M_TOK / 16) * 192; item += nthr) {
        const int rb = item / 192, cgp = item - rb * 192, c0 = cgp * 8, r0 = rb * 16;
        float w[4][8], bb[8];
#pragma unroll
        for (int k = 0; k < 4; ++k) { const f32x4 a = *(const f32x4*)(cw + k * DR + c0), b = *(const f32x4*)(cw + k * DR + c0 + 4);
#pragma unroll
            for (int j = 0; j < 4; ++j) { w[k][j] = a[j]; w[k][4 + j] = b[j]; } }
        { const f32x4 a = *(const f32x4*)(cb + c0), b = *(const f32x4*)(cb + c0 + 4);
#pragma unroll
          for (int j = 0; j < 4; ++j) { bb[j] = a[j]; bb[4 + j] = b[j]; } }
        float p1[8], p2[8], p3[8];
        const bf16_t* up = U + (size_t)r0 * DR + c0;
        if ((r0 & (SEQ - 1)) == 0) {
#pragma unroll
            for (int e = 0; e < 8; ++e) { p1[e] = 0.f; p2[e] = 0.f; p3[e] = 0.f; }
        } else {
            unpack8(*(const u32x4*)(up - DR), p1); unpack8(*(const u32x4*)(up - 2 * DR), p2); unpack8(*(const u32x4*)(up - 3 * DR), p3);
        }
        bf16_t* op = UC + (size_t)r0 * DR + c0;
#pragma unroll
        for (int i = 0; i < 16; ++i) {
            float cur[8], o[8]; unpack8(*(const u32x4*)(up + (size_t)i * DR), cur);
#pragma unroll
            for (int e = 0; e < 8; ++e) { o[e] = bb[e] + w[0][e] * p3[e] + w[1][e] * p2[e] + w[2][e] * p1[e] + w[3][e] * cur[e]; p3[e] = p2[e]; p2[e] = p1[e]; p1[e] = cur[e]; }
            *(u32x4*)(op + (size_t)i * DR) = pack8(o);
        }
    }
}
__device__ __forceinline__ void scan1_phase(const bf16_t* LA, const bf16_t* BB, float* SA, float* SH) {
    const int nthr = gdim_() * NTHR;
    for (int item = bid_() * NTHR + tid_(); item < 512 * 192; item += nthr) {
        const int bj = item / 192, cv = item - bj * 192;
        const bf16_t* pl = LA + (size_t)bj * 64 * DR + cv * 8; const bf16_t* pb = BB + (size_t)bj * 64 * DR + cv * 8;
        float A[8], h[8];
#pragma unroll
        for (int e = 0; e < 8; ++e) { A[e] = 1.f; h[e] = 0.f; }
#pragma unroll 4
        for (int i = 0; i < 64; ++i) {
            float la[8], b[8]; unpack8(*(const u32x4*)(pl + (size_t)i * DR), la); unpack8(*(const u32x4*)(pb + (size_t)i * DR), b);
#pragma unroll
            for (int e = 0; e < 8; ++e) { const float a = fast_exp(la[e]); A[e] *= a; h[e] = a * h[e] + b[e]; }
        }
        float* sa = SA + (size_t)bj * DR + cv * 8; float* sh = SH + (size_t)bj * DR + cv * 8;
        *(f32x4*)sa = (f32x4){A[0], A[1], A[2], A[3]}; *(f32x4*)(sa + 4) = (f32x4){A[4], A[5], A[6], A[7]};
        *(f32x4*)sh = (f32x4){h[0], h[1], h[2], h[3]}; *(f32x4*)(sh + 4) = (f32x4){h[4], h[5], h[6], h[7]};
    }
}
__device__ __forceinline__ void scan3_phase(const bf16_t* LA, const bf16_t* BB, const float* SA, const float* SH, bf16_t* YG) {
    const int nthr = gdim_() * NTHR;
    for (int item = bid_() * NTHR + tid_(); item < 512 * 192; item += nthr) {
        const int bj = item / 192, cv = item - bj * 192, j = bj & 63, b0 = bj - j;
        float h[8];
#pragma unroll
        for (int e = 0; e < 8; ++e) h[e] = 0.f;
#pragma unroll 4
        for (int i = 0; i < j; ++i) {
            const float* sa = SA + (size_t)(b0 + i) * DR + cv * 8; const float* sh = SH + (size_t)(b0 + i) * DR + cv * 8;
            const f32x4 a0 = *(const f32x4*)sa, a1 = *(const f32x4*)(sa + 4), h0 = *(const f32x4*)sh, h1 = *(const f32x4*)(sh + 4);
#pragma unroll
            for (int e = 0; e < 4; ++e) { h[e] = a0[e] * h[e] + h0[e]; h[4 + e] = a1[e] * h[4 + e] + h1[e]; }
        }
        const bf16_t* pl = LA + (size_t)bj * 64 * DR + cv * 8; const bf16_t* pb = BB + (size_t)bj * 64 * DR + cv * 8; bf16_t* py = YG + (size_t)bj * 64 * DR + cv * 8;
#pragma unroll 4
        for (int i = 0; i < 64; ++i) {
            float la[8], b[8], y[8], o[8]; unpack8(*(const u32x4*)(pl + (size_t)i * DR), la); unpack8(*(const u32x4*)(pb + (size_t)i * DR), b); unpack8(*(const u32x4*)(py + (size_t)i * DR), y);
#pragma unroll
            for (int e = 0; e < 8; ++e) { const float a = fast_exp(la[e]); h[e] = a * h[e] + b[e]; o[e] = h[e] * y[e]; }
            *(u32x4*)(py + (size_t)i * DR) = pack8(o);
        }
    }
}
__device__ __forceinline__ void pool_phase(const bf16_t* U, bf16_t* Z) {
    const int nthr = gdim_() * NTHR;
    for (int item = bid_() * NTHR + tid_(); item < (M_TOK / 32) * 128; item += nthr) {
        const int rb = item >> 7, cgp = item & 127, c0 = cgp * 8, w = 2 << (cgp >> 5), r0 = rb * 32, t0 = r0 & (SEQ - 1);
        const bf16_t* up = U + (size_t)r0 * DM + c0; bf16_t* zp = Z + (size_t)r0 * DM + c0;
        float sum[8];
#pragma unroll
        for (int e = 0; e < 8; ++e) sum[e] = 0.f;
        if (t0 != 0) for (int k = 1; k <= w; ++k) { float v[8]; unpack8(*(const u32x4*)(up - (size_t)k * DM), v);
#pragma unroll
            for (int e = 0; e < 8; ++e) sum[e] += v[e]; }
#pragma unroll 4
        for (int i = 0; i < 32; ++i) {
            const int t = t0 + i; float cur[8], o[8]; unpack8(*(const u32x4*)(up + (size_t)i * DM), cur);
#pragma unroll
            for (int e = 0; e < 8; ++e) sum[e] += cur[e];
            if (t >= w) { float old[8]; unpack8(*(const u32x4*)(up + (size_t)(i - w) * DM), old);
#pragma unroll
                for (int e = 0; e < 8; ++e) sum[e] -= old[e]; }
            const int cnt = (t + 1 < w) ? (t + 1) : w; const float rc = 1.0f / (float)cnt;
#pragma unroll
            for (int e = 0; e < 8; ++e) o[e] = sum[e] * rc - cur[e];
            *(u32x4*)(zp + (size_t)i * DM) = pack8(o);
        }
    }
}

__global__ void __launch_bounds__(NTHR, 2) mk_fwd(Args args) {
    extern __shared__ __attribute__((aligned(16))) unsigned char shm[];
    LAS unsigned char* lds = (LAS unsigned char*)shm;
    cg::grid_group grid = cg::this_grid();
    const int lo = args.ph_lo, hi = args.ph_hi;
    const kptr_t kp0 = (kptr_t)__builtin_amdgcn_kernarg_segment_ptr();
    int ph = 0;
#define RUN (ph >= lo && ph < hi)
#define SEAM do { if (ph >= lo && ph + 1 < hi) grid.sync(); ++ph; } while (0)
#define PH_SETUP kptr_t kp = kp0; asm volatile("" : "+s"(kp)); unsigned char* const ws = kws(kp); const int G = gdim_(), bid = bid_(); (void)G; (void)bid;
#define WSP(T, off) ((T*)(ws + (off)))

    if (RUN) {
        PH_SETUP
        cvt_rows(kin(kp, 0), WSP(bf16_t, OFF_B3), (size_t)M_TOK * DM / 8);
        conv_wmix(lds, kp, 0, WSP(bf16_t, OFF_WMIX));
        if (bid == 0) { const float* lam = kin(kp, 9); float* nsp = WSP(float, OFF_NSP); for (int i = tid_(); i < 2 * DR; i += NTHR) nsp[i] = -8.0f * log1pf(expf(-lam[i])); }
    }
    SEAM;
#pragma unroll 1
    for (int layer = 0; layer < 4; ++layer) {
        const bool isA = !(layer & 1); const int slot = layer >> 1;
        if (RUN) {
            PH_SETUP
            pg8::Gemm g{WSP(bf16_t, OFF_B3), WSP(bf16_t, OFF_WMIX), M_TOK, isA ? 2 * DR : DM, DM, DM, 0, 0};
            pg8::StaticOrder S; S.init(g.M, g.N, G, bid);
            EpiG1 E{WSP(bf16_t, OFF_B1), isA ? DR : DM, WSP(bf16_t, OFF_B2), DR, isA ? 6 : 4};
            pg8::gemm_phase(lds, g, S, E);
        }
        SEAM;
        if (isA) {
            if (RUN) {
                PH_SETUP
                conv_phase(WSP(bf16_t, OFF_B1), WSP(bf16_t, OFF_B3), kin(kp, 3) + (size_t)slot * 4 * DR, kin(kp, 4) + (size_t)slot * DR);
                conv_wmlp(lds, kp, layer, WSP(bf16_t, OFF_WMLP));
            }
            SEAM;
            if (RUN) {
                PH_SETUP
                pg8::Gemm g{WSP(bf16_t, OFF_B3), WSP(bf16_t, OFF_WMIX) + WA_GT, M_TOK, 12 * 256, 256, DR, 1, 256};
                pg8::StaticOrder S; S.init(g.M, g.N, G, bid);
                EpiGates E{WSP(bf16_t, OFF_B1), WSP(bf16_t, OFF_B4), WSP(bf16_t, OFF_B3), kin(kp, 6) + (size_t)slot * DR, kin(kp, 8) + (size_t)slot * DR, WSP(float, OFF_NSP) + (size_t)slot * DR};
                pg8::gemm_phase(lds, g, S, E);
            }
            SEAM;
            if (RUN) { PH_SETUP scan1_phase(WSP(bf16_t, OFF_B1), WSP(bf16_t, OFF_B4), WSP(float, OFF_SUMA), WSP(float, OFF_SUMH)); }
            SEAM;
            if (RUN) { PH_SETUP scan3_phase(WSP(bf16_t, OFF_B1), WSP(bf16_t, OFF_B4), WSP(float, OFF_SUMA), WSP(float, OFF_SUMH), WSP(bf16_t, OFF_B2)); }
            SEAM;
        } else {
            if (RUN) {
                PH_SETUP
                pool_phase(WSP(bf16_t, OFF_B1), WSP(bf16_t, OFF_B2));
                conv_wmlp(lds, kp, layer, WSP(bf16_t, OFF_WMLP));
            }
            SEAM;
            if (RUN) {
                PH_SETUP
                pg8::Gemm g{WSP(bf16_t, OFF_B2), WSP(bf16_t, OFF_WMIX) + WB_GT, M_TOK, DM, 256, DM, 0, 256};
                pg8::StaticOrder S; S.init(g.M, g.N, G, bid);
                EpiStore<2> E{WSP(bf16_t, OFF_B3), DM, kin(kp, 13) + (size_t)slot * DM, kin(kp, 14) + (size_t)slot * DM};
                pg8::gemm_phase(lds, g, S, E);
            }
            SEAM;
        }
        if (RUN) {
            PH_SETUP
            float* const X = kout(kp);
            pg8::Gemm g{isA ? WSP(bf16_t, OFF_B2) : WSP(bf16_t, OFF_B3), WSP(bf16_t, OFF_WMIX) + (isA ? WA_OUT : WB_OUT), M_TOK, DM, isA ? DR : DM, isA ? DR : DM, 0, 0};
            pg8::StaticOrder S; S.init(g.M, g.N, G, bid);
            EpiResid E{layer == 0 ? kin(kp, 0) : (const float*)X, X};
            pg8::gemm_phase(lds, g, S, E);
        }
        SEAM;
        if (RUN) {
            PH_SETUP
            ln_rows(kout(kp), WSP(bf16_t, OFF_XB), kin(kp, 16) + (size_t)layer * DM, kin(kp, 17) + (size_t)layer * DM);
            cvt_rows(kin(kp, 1) + (size_t)layer * M_TOK * PLE, WSP(bf16_t, OFF_PB), (size_t)M_TOK * PLE / 8);
        }
        SEAM;
        if (RUN) {
            PH_SETUP
            pg8::Gemm g{WSP(bf16_t, OFF_XB), WSP(bf16_t, OFF_WMLP) + WM_W1, M_TOK, DFF, DM, DM, 0, 0};
            pg8::StaticOrder S; S.init(g.M, g.N, G, bid);
            EpiStore<1> E{WSP(bf16_t, OFF_B1), DFF, nullptr, nullptr};
            pg8::gemm_phase(lds, g, S, E);
        }
        SEAM;
        if (RUN) {
            PH_SETUP
            float* const X = kout(kp);
            pg8::Gemm g{WSP(bf16_t, OFF_B1), WSP(bf16_t, OFF_WMLP) + WM_W2, M_TOK, DM, DFF, DFF, 0, 0};
            pg8::StaticOrder S; S.init(g.M, g.N, G, bid);
            EpiResid E{(const float*)X, X};
            pg8::gemm_phase(lds, g, S, E);
        }
        SEAM;
        if (RUN) {
            PH_SETUP
            ln_rows(kout(kp), WSP(bf16_t, OFF_XB), kin(kp, 20) + (size_t)layer * DM, kin(kp, 21) + (size_t)layer * DM);
            if (layer < 3) conv_wmix(lds, kp, layer + 1, WSP(bf16_t, OFF_WMIX));
        }
        SEAM;
        if (RUN) {
            {
                PH_SETUP
                pg8::Gemm g{WSP(bf16_t, OFF_PB), WSP(bf16_t, OFF_WMLP) + WM_PLE, M_TOK, DM, PLE, PLE, 0, 0};
                pg8::StaticOrder S; S.init(g.M, g.N, G, bid);
                EpiStore<0> E{WSP(bf16_t, OFF_B1), DM, nullptr, nullptr};
                pg8::gemm_phase(lds, g, S, E);
            }
            {
                PH_SETUP
                pg8::Gemm g{WSP(bf16_t, OFF_XB), WSP(bf16_t, OFF_WMLP) + WM_PG, M_TOK, DM, DM, DM, 0, 0};
                pg8::StaticOrder S; S.init(g.M, g.N, G, bid);
                EpiPle E{kout(kp), WSP(bf16_t, OFF_B1), kin(kp, 24) + (size_t)layer * DM, WSP(bf16_t, OFF_B3)};
                pg8::gemm_phase(lds, g, S, E);
            }
        }
        SEAM;
    }
#undef RUN
#undef SEAM
#undef PH_SETUP
#undef WSP
}

constexpr int N_PHASES = 1 + 2 * (11 + 9);

extern "C" void kernel_launch(void* const* d_in, const int* in_sizes, int n_in, void* d_out, int out_size, void* d_ws, size_t ws_size, hipStream_t stream) {
    static int grid = 0;
    if (grid == 0) {
        int dev = 0, cus = 0, per_cu = 0;
        hipGetDevice(&dev);
        hipDeviceGetAttribute(&cus, hipDeviceAttributeMultiprocessorCount, dev);
        if (hipFuncSetAttribute((const void*)mk_fwd, hipFuncAttributeMaxDynamicSharedMemorySize, LDS_BYTES) != hipSuccess) fprintf(stderr, "kernel_launch: hipFuncSetAttribute failed\n");
        if (hipOccupancyMaxActiveBlocksPerMultiprocessor(&per_cu, (const void*)mk_fwd, NTHR, LDS_BYTES) != hipSuccess || per_cu < 1) fprintf(stderr, "kernel_launch: occupancy query says %d blocks per CU\n", per_cu);
        (void)hipGetLastError();
        grid = cus > 0 ? cus : 256;
    }
    Args a{};
    for (int i = 0; i < 25; ++i) a.in[i] = (const float*)d_in[i];
    a.out = (float*)d_out; a.ws = (unsigned char*)d_ws;
    void* params[] = {&a};
#if ONE_LAUNCH
    a.ph_lo = 0; a.ph_hi = N_PHASES;
    hipError_t e = hipLaunchCooperativeKernel((const void*)mk_fwd, dim3(grid), dim3(NTHR), params, LDS_BYTES, stream);
    if (e != hipSuccess) fprintf(stderr, "kernel_launch: cooperative launch failed: %s (grid %d)\n", hipGetErrorString(e), grid);
#else
    for (int p = 0; p < N_PHASES; ++p) {
        a.ph_lo = p; a.ph_hi = p + 1;
        hipError_t e = hipLaunchCooperativeKernel((const void*)mk_fwd, dim3(grid), dim3(NTHR), params, LDS_BYTES, stream);
        if (e != hipSuccess) { fprintf(stderr, "kernel_launch: launch %d failed: %s (grid %d)\n", p, hipGetErrorString(e), grid); break; }
    }
#endif
}
```

```cpp
#include <hip/hip_runtime.h>
#include <hip/hip_cooperative_groups.h>
#include <cstdio>
namespace cg = cooperative_groups;

#ifndef ONE_LAUNCH
#define ONE_LAUNCH 1
#endif

#define LAS __attribute__((address_space(3)))
typedef unsigned short bf16_t;
typedef short bf16x8 __attribute__((ext_vector_type(8)));
typedef float f32x4 __attribute__((ext_vector_type(4)));
typedef unsigned u32x4 __attribute__((ext_vector_type(4)));
typedef unsigned u32x2 __attribute__((ext_vector_type(2)));

constexpr int M_TOK = 32768, DM = 1024, DR = 1536, DFF = 4096, SEQ = 4096, PLE = 256;
constexpr float ALPHA_F = 1.681792830507429f;
constexpr float LN_EPS_F = 1e-5f;
constexpr int NTHR = 512;
constexpr int LDS_STAGE = 131072;
constexpr int LDS_BYTES = LDS_STAGE + 64;

constexpr size_t MiB = 1024ull * 1024ull;
constexpr size_t OFF_WMIX = 0;
constexpr size_t OFF_WMLP = 12 * MiB;
constexpr size_t OFF_XB   = 32 * MiB;
constexpr size_t OFF_REG  = 96 * MiB;
constexpr size_t OFF_B1   = OFF_REG;
constexpr size_t OFF_B2   = OFF_REG + 96 * MiB;
constexpr size_t OFF_B3   = OFF_REG + 192 * MiB;
constexpr size_t OFF_B4   = OFF_REG + 288 * MiB;
constexpr size_t OFF_PB   = OFF_REG + 256 * MiB;
constexpr size_t OFF_SUMA = 480 * MiB;
constexpr size_t OFF_SUMH = 483 * MiB;
constexpr size_t OFF_NSP  = 486 * MiB;
constexpr size_t OFF_BAR  = 487 * MiB;
constexpr size_t WA_IN = 0, WA_GT = 3145728, WA_OUT = 3932160;
constexpr size_t WB_IN = 0, WB_GT = 1048576, WB_OUT = 1310720;
constexpr size_t WM_W1 = 0, WM_W2 = 4194304, WM_PLE = 8388608, WM_PG = 8650752;

struct Args { const float* in[25]; float* out; unsigned char* ws; int ph_lo, ph_hi; };

__device__ __forceinline__ int tid_() { int t = threadIdx.x; asm volatile("" : "+v"(t)); return t; }
__device__ __forceinline__ int bid_() { int t = blockIdx.x; asm volatile("" : "+s"(t)); return t; }
__device__ __forceinline__ int gdim_() { int t = gridDim.x; asm volatile("" : "+s"(t)); return t; }
__device__ __forceinline__ unsigned cvt_pk_bf16(float lo, float hi) { unsigned r; asm volatile("v_cvt_pk_bf16_f32 %0, %1, %2" : "=v"(r) : "v"(lo), "v"(hi)); return r; }
__device__ __forceinline__ float bf_lo(unsigned w) { return __uint_as_float(w << 16); }
__device__ __forceinline__ float bf_hi(unsigned w) { return __uint_as_float(w & 0xffff0000u); }
__device__ __forceinline__ float fast_exp(float x) { return __builtin_amdgcn_exp2f(x * 1.4426950408889634f); }
__device__ __forceinline__ float sigmoidf_(float x) { return __builtin_amdgcn_rcpf(1.0f + __builtin_amdgcn_exp2f(-1.4426950408889634f * x)); }
__device__ __forceinline__ float gelu_tanh(float v) { const float in = v + 0.044715f * v * v * v; return v * __builtin_amdgcn_rcpf(1.0f + __builtin_amdgcn_exp2f(-2.302208198f * in)); }
__device__ __forceinline__ void unpack8(const u32x4 w, float (&f)[8]) {
    f[0] = bf_lo(w.x); f[1] = bf_hi(w.x); f[2] = bf_lo(w.y); f[3] = bf_hi(w.y); f[4] = bf_lo(w.z); f[5] = bf_hi(w.z); f[6] = bf_lo(w.w); f[7] = bf_hi(w.w); }
__device__ __forceinline__ u32x4 pack8(const float (&f)[8]) { u32x4 w; w.x = cvt_pk_bf16(f[0], f[1]); w.y = cvt_pk_bf16(f[2], f[3]); w.z = cvt_pk_bf16(f[4], f[5]); w.w = cvt_pk_bf16(f[6], f[7]); return w; }

namespace pg8 {
constexpr int BM = 256, BK = 64, HALF = 128, HTB = HALF * BK * 2, STAGE_BYTES = 8 * HTB, NXCD = 8, WGM = 8;
__device__ __forceinline__ int lds_byte(int r, int c) { const int st = (r >> 4) * 2 + (c >> 5), rr = r & 15, cc = c & 31, ob = rr * 64 + cc * 2; return st * 1024 + (ob ^ (((ob >> 9) & 1) << 5)); }
__device__ __forceinline__ void stage_rc(int b, int& R, int& C) { const int st = b / 1024, sb = b % 1024, swz = sb ^ (((sb >> 9) & 1) << 5); R = (st >> 1) * 16 + swz / 64; C = (st & 1) * 32 + (swz % 64) / 2; }
__device__ __forceinline__ int perm32(int rho) { const int n = rho >> 4, i = rho & 15; return 8 * (i >> 2) + 4 * n + (i & 3); }

struct Unit { int pm, pn; };
struct Gemm { const bf16_t* A; const bf16_t* Bt; int M, N, K, lda, a_shift, a_step; };

struct StaticOrder {
    int nM, nN, nwg, G, c;
    __device__ void init(int M, int N, int G_, int c_) { nM = M / BM; nN = N / BM; nwg = nM * nN; G = G_; c = c_; }
    __device__ bool next(int i, Unit& u) const {
        const long L = (long)i * G + c; if (L >= nwg) return false;
        int wgid = (int)L; { const int q = nwg / NXCD, r = nwg % NXCD, xcd = wgid % NXCD, off = wgid / NXCD; wgid = (xcd < r ? xcd * (q + 1) : r * (q + 1) + (xcd - r) * q) + off; }
        const int nig = WGM * nN, gid = wgid / nig, fm = gid * WGM, gsz = (nM - fm) < WGM ? (nM - fm) : WGM;
        u.pm = fm + ((wgid % nig) % gsz); u.pn = (wgid % nig) / gsz; return true;
    }
};

template <class Epi>
__device__ __forceinline__ void gemm_phase(LAS unsigned char* lds, const Gemm g, const StaticOrder& S, const Epi& E) {
    const int tid = tid_(), wid = __builtin_amdgcn_readfirstlane(tid >> 6), lane = tid & 63, wr = wid >> 2, wc = wid & 3, fr = lane & 15, fq = lane >> 4;
    const int K = g.K, nt = K / BK, lda = g.lda;
    unsigned voffA[2], voffB[2];
#pragma unroll
    for (int i = 0; i < 2; ++i) { int R, C; stage_rc(tid * 16 + i * 8192, R, C); const int Rb = (R & ~31) + perm32(R & 31);
        voffA[i] = (unsigned)(R * lda + C) * 2u; voffB[i] = (unsigned)(Rb * K + C) * 2u; }
    const size_t kstep = (size_t)(BK * 2);
    const size_t hstepA = (size_t)HALF * lda * 2, hstepB = (size_t)HALF * K * 2;
    const unsigned ldsw = (unsigned)wid * 1024u;
    const int aoff = lds_byte(wr * 64 + fr, fq * 8), boff = lds_byte(wc * 32 + fr, fq * 8);
#define PG8_SA(b, h) (((b) * 2 + (h)) * HTB)
#define PG8_SB(b, h) ((4 + (b) * 2 + (h)) * HTB)
#define PG8_STAGE(bufoff, gbase, voff) do { _Pragma("unroll") for (int _i = 0; _i < 2; ++_i) \
        __builtin_amdgcn_global_load_lds((const unsigned*)((const char*)(gbase) + (voff)[_i]), (LAS unsigned*)(lds + (bufoff) + ldsw + _i * 8192), 16, 0, 0); } while (0)
#define PG8_LDA(dst, b, h) do { _Pragma("unroll") for (int m = 0; m < 4; ++m) _Pragma("unroll") for (int k = 0; k < 2; ++k) dst[m][k] = *(const LAS bf16x8*)(lds + PG8_SA(b, h) + aoff + m * 2048 + k * 1024); } while (0)
#define PG8_LDB(dst, b, h) do { _Pragma("unroll") for (int n = 0; n < 2; ++n) _Pragma("unroll") for (int k = 0; k < 2; ++k) dst[n][k] = *(const LAS bf16x8*)(lds + PG8_SB(b, h) + boff + n * 2048 + k * 1024); } while (0)
#define PG8_MMA(ai, bj, At, Bt) do { __builtin_amdgcn_s_setprio(1); _Pragma("unroll") for (int m = 0; m < 4; ++m) _Pragma("unroll") for (int n = 0; n < 2; ++n) _Pragma("unroll") for (int k = 0; k < 2; ++k) \
        acc[ai][bj][m][n] = __builtin_amdgcn_mfma_f32_16x16x32_bf16(Bt[n][k], At[m][k], acc[ai][bj][m][n], 0, 0, 0); __builtin_amdgcn_s_setprio(0); } while (0)
#define PG8_WAIT_V(n) asm volatile("s_waitcnt vmcnt(" #n ")" ::: "memory")
#define PG8_WAIT_L(n) asm volatile("s_waitcnt lgkmcnt(" #n ")" ::: "memory")
#define PG8_BAR __builtin_amdgcn_s_barrier()
#define PG8_SCHED __builtin_amdgcn_sched_barrier(0)
#define PG8_UNITA(u) ((const char*)g.A + (size_t)(u).pm * 2 * hstepA + (size_t)(((u).pn >> g.a_shift) * g.a_step) * 2)
#define PG8_UNITB(u) ((const char*)g.Bt + (size_t)(u).pn * 2 * hstepB)
    Unit cur, nxt; int ui = 0;
    if (!S.next(0, cur)) return;
    float zf = 0.f; asm volatile("" : "+v"(zf));
    f32x4 acc[2][2][4][2];
#pragma unroll
    for (int a = 0; a < 2; ++a)
#pragma unroll
        for (int b = 0; b < 2; ++b)
#pragma unroll
            for (int m = 0; m < 4; ++m)
#pragma unroll
                for (int n = 0; n < 2; ++n) acc[a][b][m][n] = (f32x4){zf, zf, zf, zf};
    bf16x8 At[4][2], B0[2][2], B1[2][2];
    const char* cA = PG8_UNITA(cur); const char* cB = PG8_UNITB(cur);
    PG8_STAGE(PG8_SB(0, 0), cB, voffB); PG8_STAGE(PG8_SA(0, 0), cA, voffA); PG8_STAGE(PG8_SB(0, 1), cB + hstepB, voffB); PG8_STAGE(PG8_SA(0, 1), cA + hstepA, voffA);
    if (wr == 1) PG8_BAR;
    PG8_WAIT_V(4); PG8_BAR;
    PG8_STAGE(PG8_SB(1, 0), cB + kstep, voffB); PG8_STAGE(PG8_SA(1, 0), cA + kstep, voffA); PG8_STAGE(PG8_SB(1, 1), cB + hstepB + kstep, voffB);
    PG8_WAIT_V(6); PG8_BAR;
    for (;;) {
        const bool has_next = S.next(ui + 1, nxt);
        const char* nA = has_next ? PG8_UNITA(nxt) : cA; const char* nB = has_next ? PG8_UNITB(nxt) : cB;
        for (int t = 0; t < nt; t += 2) {
            const bool last = (t == nt - 2);
            const char* a1 = cA + (size_t)(t + 1) * kstep;
            const char* a2 = last ? nA : cA + (size_t)(t + 2) * kstep; const char* b2 = last ? nB : cB + (size_t)(t + 2) * kstep;
            const char* a3 = a2 + kstep; const char* b3 = b2 + kstep;
            PG8_LDB(B0, 0, 0); PG8_SCHED; PG8_LDA(At, 0, 0); PG8_STAGE(PG8_SA(1, 1), a1 + hstepA, voffA);
            PG8_WAIT_L(8); PG8_BAR; PG8_WAIT_L(0); PG8_MMA(0, 0, At, B0); PG8_BAR; PG8_SCHED;
            PG8_LDB(B1, 0, 1); PG8_STAGE(PG8_SB(0, 0), b2, voffB);
            PG8_BAR; PG8_WAIT_L(0); PG8_MMA(0, 1, At, B1); PG8_BAR;
            PG8_LDA(At, 0, 1); PG8_STAGE(PG8_SA(0, 0), a2, voffA);
            PG8_BAR; PG8_WAIT_L(0); PG8_MMA(1, 0, At, B0); PG8_BAR; PG8_SCHED;
            PG8_STAGE(PG8_SB(0, 1), b2 + hstepB, voffB);
            PG8_WAIT_V(6); PG8_BAR; PG8_MMA(1, 1, At, B1); PG8_BAR;
            PG8_LDB(B0, 1, 0); PG8_SCHED; PG8_LDA(At, 1, 0); PG8_STAGE(PG8_SA(0, 1), a2 + hstepA, voffA);
            PG8_WAIT_L(8); PG8_BAR; PG8_WAIT_L(0); PG8_MMA(0, 0, At, B0); PG8_BAR; PG8_SCHED;
            PG8_LDB(B1, 1, 1); PG8_STAGE(PG8_SB(1, 0), b3, voffB);
            PG8_BAR; PG8_WAIT_L(0); PG8_MMA(0, 1, At, B1); PG8_BAR;
            PG8_LDA(At, 1, 1); PG8_STAGE(PG8_SA(1, 0), a3, voffA);
            PG8_BAR; PG8_WAIT_L(0); PG8_MMA(1, 0, At, B0); PG8_BAR; PG8_SCHED;
            PG8_STAGE(PG8_SB(1, 1), b3 + hstepB, voffB);
            PG8_WAIT_V(6); PG8_BAR; PG8_MMA(1, 1, At, B1); PG8_BAR;
        }
        E(acc, cur, wr, wc, fr, fq);
        if (!has_next) break;
#pragma unroll
        for (int a = 0; a < 2; ++a)
#pragma unroll
            for (int b = 0; b < 2; ++b)
#pragma unroll
                for (int m = 0; m < 4; ++m)
#pragma unroll
                    for (int n = 0; n < 2; ++n) acc[a][b][m][n] = (f32x4){zf, zf, zf, zf};
        cur = nxt; cA = nA; cB = nB; ++ui;
    }
    PG8_WAIT_V(0);
    if (wr == 0) PG8_BAR;
    PG8_BAR;
#undef PG8_SA
#undef PG8_SB
#undef PG8_STAGE
#undef PG8_LDA
#undef PG8_LDB
#undef PG8_MMA
#undef PG8_WAIT_V
#undef PG8_WAIT_L
#undef PG8_BAR
#undef PG8_SCHED
#undef PG8_UNITA
#undef PG8_UNITB
}
}

typedef f32x4 AccT[2][2][4][2];

struct EpiG1 {
    bf16_t* U; int ldu; bf16_t* Y; int ldy; int nsplit;
    __device__ __forceinline__ void operator()(const AccT& acc, const pg8::Unit& u, int wr, int wc, int fr, int fq) const {
        const int row0 = u.pm * 256 + wr * 64 + fr;
        bf16_t* base; int ld, colt; bool act;
        if (u.pn < nsplit) { base = U; ld = ldu; colt = u.pn * 256; act = false; } else { base = Y; ld = ldy; colt = (u.pn - nsplit) * 256; act = true; }
        const int col0 = colt + wc * 32 + 8 * fq;
#pragma unroll
        for (int ai = 0; ai < 2; ++ai)
#pragma unroll
            for (int m = 0; m < 4; ++m) { bf16_t* rowp = base + (size_t)(row0 + ai * 128 + m * 16) * ld + col0;
#pragma unroll
                for (int bj = 0; bj < 2; ++bj) { f32x4 v0 = acc[ai][bj][m][0], v1 = acc[ai][bj][m][1];
                    if (act) {
#pragma unroll
                        for (int j = 0; j < 4; ++j) { v0[j] = gelu_tanh(v0[j]); v1[j] = gelu_tanh(v1[j]); } }
                    u32x4 w; w.x = cvt_pk_bf16(v0[0], v0[1]); w.y = cvt_pk_bf16(v0[2], v0[3]); w.z = cvt_pk_bf16(v1[0], v1[1]); w.w = cvt_pk_bf16(v1[2], v1[3]);
                    *(u32x4*)(rowp + bj * 128) = w; } }
    }
};
template <int ACT> struct EpiStore {
    bf16_t* O; int ldo; const float* bias; const float* scale;
    __device__ __forceinline__ void operator()(const AccT& acc, const pg8::Unit& u, int wr, int wc, int fr, int fq) const {
        const int row0 = u.pm * 256 + wr * 64 + fr, col0 = u.pn * 256 + wc * 32 + 8 * fq;
#pragma unroll
        for (int bj = 0; bj < 2; ++bj) {
            f32x4 bv[2], sv[2];
            if (ACT == 2) {
#pragma unroll
                for (int n = 0; n < 2; ++n) { bv[n] = *(const f32x4*)(bias + col0 + bj * 128 + 4 * n); sv[n] = *(const f32x4*)(scale + col0 + bj * 128 + 4 * n); } }
#pragma unroll
            for (int ai = 0; ai < 2; ++ai)
#pragma unroll
                for (int m = 0; m < 4; ++m) { bf16_t* rowp = O + (size_t)(row0 + ai * 128 + m * 16) * ldo + col0;
                    f32x4 v0 = acc[ai][bj][m][0], v1 = acc[ai][bj][m][1];
                    if (ACT == 1) {
#pragma unroll
                        for (int j = 0; j < 4; ++j) { const float a = fmaxf(v0[j], 0.f), b = fmaxf(v1[j], 0.f); v0[j] = a * a; v1[j] = b * b; } }
                    if (ACT == 2) { v0 = (v0 + bv[0]) * sv[0]; v1 = (v1 + bv[1]) * sv[1]; }
                    u32x4 w; w.x = cvt_pk_bf16(v0[0], v0[1]); w.y = cvt_pk_bf16(v0[2], v0[3]); w.z = cvt_pk_bf16(v1[0], v1[1]); w.w = cvt_pk_bf16(v1[2], v1[3]);
                    *(u32x4*)(rowp + bj * 128) = w; }
            __builtin_amdgcn_sched_barrier(0);
        }
    }
};
struct EpiResid {
    const float* xres; float* out;
    __device__ __forceinline__ void operator()(const AccT& acc, const pg8::Unit& u, int wr, int wc, int fr, int fq) const {
        const int row0 = u.pm * 256 + wr * 64 + fr, col0 = u.pn * 256 + wc * 32 + 8 * fq;
#pragma unroll
        for (int ai = 0; ai < 2; ++ai)
#pragma unroll
            for (int m = 0; m < 4; ++m) { const size_t ro = (size_t)(row0 + ai * 128 + m * 16) * DM + col0;
#pragma unroll
                for (int bj = 0; bj < 2; ++bj)
#pragma unroll
                    for (int n = 0; n < 2; ++n) { const f32x4 xv = *(const f32x4*)(xres + ro + bj * 128 + 4 * n);
                        *(f32x4*)(out + ro + bj * 128 + 4 * n) = acc[ai][bj][m][n] + ALPHA_F * xv; } }
    }
};
struct EpiGates {
    bf16_t* LA; bf16_t* BB; const bf16_t* UC; const float* ba; const float* bx; const float* nsp;
    __device__ __forceinline__ void operator()(const AccT& acc, const pg8::Unit& u, int wr, int wc, int fr, int fq) const {
        const int row0 = u.pm * 256 + wr * 64 + fr, ch0 = u.pn * 128 + wc * 32 + 8 * fq;
#pragma unroll
        for (int n = 0; n < 2; ++n) {
            const f32x4 bav = *(const f32x4*)(ba + ch0 + 4 * n), bxv = *(const f32x4*)(bx + ch0 + 4 * n), nsv = *(const f32x4*)(nsp + ch0 + 4 * n);
#pragma unroll
            for (int ai = 0; ai < 2; ++ai)
#pragma unroll
                for (int m = 0; m < 4; ++m) { const int row = row0 + ai * 128 + m * 16; const size_t ro = (size_t)row * DR + ch0 + 4 * n;
                    const bool t0 = (row & (SEQ - 1)) == 0;
                    const u32x2 ucw = *(const u32x2*)(UC + ro);
                    const float uc[4] = {bf_lo(ucw.x), bf_hi(ucw.x), bf_lo(ucw.y), bf_hi(ucw.y)};
                    float lo[4], bo[4];
#pragma unroll
                    for (int j = 0; j < 4; ++j) {
                        const float r = sigmoidf_(acc[ai][0][m][n][j] + bav[j]);
                        const float ig = sigmoidf_(acc[ai][1][m][n][j] + bxv[j]);
                        const float la = nsv[j] * r;
                        const float a2 = __builtin_amdgcn_exp2f(la * 2.8853900817779268f);
                        const float mult = t0 ? 1.0f : __builtin_amdgcn_sqrtf(fmaxf(1.0f - a2, 0.f));
                        lo[j] = la; bo[j] = mult * ig * uc[j]; }
                    u32x2 wl, wb; wl.x = cvt_pk_bf16(lo[0], lo[1]); wl.y = cvt_pk_bf16(lo[2], lo[3]); wb.x = cvt_pk_bf16(bo[0], bo[1]); wb.y = cvt_pk_bf16(bo[2], bo[3]);
                    *(u32x2*)(LA + ro) = wl; *(u32x2*)(BB + ro) = wb; }
            __builtin_amdgcn_sched_barrier(0);
        }
    }
};
struct EpiPle {
    float* X; const bf16_t* T; const float* bg; bf16_t* XIN;
    __device__ __forceinline__ void operator()(const AccT& acc, const pg8::Unit& u, int wr, int wc, int fr, int fq) const {
        const int row0 = u.pm * 256 + wr * 64 + fr, col0 = u.pn * 256 + wc * 32 + 8 * fq;
        f32x4 bv[2][2];
#pragma unroll
        for (int bj = 0; bj < 2; ++bj)
#pragma unroll
            for (int n = 0; n < 2; ++n) bv[bj][n] = *(const f32x4*)(bg + col0 + bj * 128 + 4 * n);
#pragma unroll
        for (int ai = 0; ai < 2; ++ai)
#pragma unroll
            for (int m = 0; m < 4; ++m) { const size_t ro = (size_t)(row0 + ai * 128 + m * 16) * DM + col0;
#pragma unroll
                for (int bj = 0; bj < 2; ++bj) {
                    const u32x4 tw = *(const u32x4*)(T + ro + bj * 128); float tv[8]; unpack8(tw, tv);
                    const f32x4 x0 = *(const f32x4*)(X + ro + bj * 128), x1 = *(const f32x4*)(X + ro + bj * 128 + 4);
                    f32x4 o0, o1;
#pragma unroll
                    for (int j = 0; j < 4; ++j) { o0[j] = x0[j] + tv[j] * sigmoidf_(acc[ai][bj][m][0][j] + bv[bj][0][j]); o1[j] = x1[j] + tv[4 + j] * sigmoidf_(acc[ai][bj][m][1][j] + bv[bj][1][j]); }
                    *(f32x4*)(X + ro + bj * 128) = o0; *(f32x4*)(X + ro + bj * 128 + 4) = o1;
                    u32x4 w; w.x = cvt_pk_bf16(o0[0], o0[1]); w.y = cvt_pk_bf16(o0[2], o0[3]); w.z = cvt_pk_bf16(o1[0], o1[1]); w.w = cvt_pk_bf16(o1[2], o1[3]);
                    *(u32x4*)(XIN + ro + bj * 128) = w; } }
    }
};

__device__ __forceinline__ void tc_mat(LAS unsigned char* lds, const float* src, int K, int N, int ld_src, bf16_t* dst, int ld_dst, int& base) {
    LAS float* s = (LAS float*)lds;
    const int G = gdim_(), tid = tid_();
    const int tn = N >> 6, ntiles = (K >> 6) * tn;
    int t0 = ((int)bid_() - base) % G; if (t0 < 0) t0 += G;
    for (int t = t0; t < ntiles; t += G) {
        const int k0 = (t / tn) << 6, n0 = (t % tn) << 6;
#pragma unroll
        for (int j = 0; j < 8; ++j) { const int idx = j * NTHR + tid, kk = idx >> 6, nn = idx & 63; s[kk * 65 + nn] = src[(size_t)(k0 + kk) * ld_src + n0 + nn]; }
        __syncthreads();
        { const int n = tid >> 3, kg = tid & 7; float v[8];
#pragma unroll
          for (int i = 0; i < 8; ++i) v[i] = s[(kg * 8 + i) * 65 + n];
          *(u32x4*)(dst + (size_t)(n0 + n) * ld_dst + k0 + kg * 8) = pack8(v); }
        __syncthreads();
    }
    base += ntiles;
}

typedef const float* cfp;
typedef const __attribute__((address_space(4))) unsigned char* kptr_t;
__device__ __forceinline__ const float* kin(kptr_t kp, int i) { return *(const __attribute__((address_space(4))) cfp*)(kp + 8 * i); }
__device__ __forceinline__ float* kout(kptr_t kp) { return *(float* const __attribute__((address_space(4)))*)(kp + 200); }
__device__ __forceinline__ unsigned char* kws(kptr_t kp) { return *(unsigned char* const __attribute__((address_space(4)))*)(kp + 208); }

__device__ __forceinline__ void conv_wmix(LAS unsigned char* lds, kptr_t kp, int layer, bf16_t* wmix) {
    int base = 0; const int slot = layer >> 1;
    if (!(layer & 1)) {
        tc_mat(lds, kin(kp, 2) + (size_t)slot * 1024 * 3072, 1024, 3072, 3072, wmix + WA_IN, 1024, base);
        const float* wa = kin(kp, 5); const float* wx = kin(kp, 7);
#pragma unroll 1
        for (int h = 0; h < 12; ++h) {
            tc_mat(lds, wa + (size_t)(slot * 12 + h) * 16384, 128, 128, 128, wmix + WA_GT + (size_t)(h * 256) * 256 + (h & 1) * 128, 256, base);
            tc_mat(lds, wx + (size_t)(slot * 12 + h) * 16384, 128, 128, 128, wmix + WA_GT + (size_t)(h * 256 + 128) * 256 + (h & 1) * 128, 256, base);
        }
        tc_mat(lds, kin(kp, 10) + (size_t)slot * 1536 * 1024, 1536, 1024, 1024, wmix + WA_OUT, 1536, base);
        unsigned zu = 0u; asm volatile("" : "+v"(zu));
        for (int it = bid_() * NTHR + tid_(); it < 12 * 256 * 16; it += gdim_() * NTHR) {
            const int seg = it & 15, rr = it >> 4, h = rr >> 8;
            *(u32x4*)(wmix + WA_GT + (size_t)rr * 256 + ((h & 1) ^ 1) * 128 + seg * 8) = (u32x4){zu, zu, zu, zu};
        }
    } else {
        tc_mat(lds, kin(kp, 11) + (size_t)slot * 1024 * 1024, 1024, 1024, 1024, wmix + WB_IN, 1024, base);
        const float* wg = kin(kp, 12);
#pragma unroll 1
        for (int g = 0; g < 4; ++g) tc_mat(lds, wg + (size_t)(slot * 4 + g) * 65536, 256, 256, 256, wmix + WB_GT + (size_t)g * 65536, 256, base);
        tc_mat(lds, kin(kp, 15) + (size_t)slot * 1024 * 1024, 1024, 1024, 1024, wmix + WB_OUT, 1024, base);
    }
}
__device__ __forceinline__ void conv_wmlp(LAS unsigned char* lds, kptr_t kp, int layer, bf16_t* wmlp) {
    int base = 0;
    tc_mat(lds, kin(kp, 18) + (size_t)layer * 1024 * 4096, 1024, 4096, 4096, wmlp + WM_W1, 1024, base);
    tc_mat(lds, kin(kp, 19) + (size_t)layer * 4096 * 1024, 4096, 1024, 1024, wmlp + WM_W2, 4096, base);
    tc_mat(lds, kin(kp, 22) + (size_t)layer * 256 * 1024, 256, 1024, 1024, wmlp + WM_PLE, 256, base);
    tc_mat(lds, kin(kp, 23) + (size_t)layer * 1024 * 1024, 1024, 1024, 1024, wmlp + WM_PG, 1024, base);
}
__device__ __forceinline__ void cvt_rows(const float* src, bf16_t* dst, size_t n8) {
    const size_t nthr = (size_t)gdim_() * NTHR;
    for (size_t i = (size_t)bid_() * NTHR + tid_(); i < n8; i += nthr) {
        const f32x4 a = *(const f32x4*)(src + i * 8), b = *(const f32x4*)(src + i * 8 + 4);
        u32x4 w; w.x = cvt_pk_bf16(a[0], a[1]); w.y = cvt_pk_bf16(a[2], a[3]); w.z = cvt_pk_bf16(b[0], b[1]); w.w = cvt_pk_bf16(b[2], b[3]);
        *(u32x4*)(dst + i * 8) = w;
    }
}
__device__ __forceinline__ void ln_rows(float* X, bf16_t* XB, const float* gam, const float* bet) {
    const int tid = tid_(), lane = tid & 63, wave = tid >> 6;
    f32x4 gv[4], bv[4];
#pragma unroll
    for (int k = 0; k < 4; ++k) { gv[k] = *(const f32x4*)(gam + k * 256 + lane * 4); bv[k] = *(const f32x4*)(bet + k * 256 + lane * 4); }
    for (int row = bid_() * 8 + wave; row < M_TOK; row += gdim_() * 8) {
        float* xr = X + (size_t)row * DM + lane * 4;
        f32x4 v[4];
#pragma unroll
        for (int k = 0; k < 4; ++k) v[k] = *(const f32x4*)(xr + k * 256);
        float s = 0.f;
#pragma unroll
        for (int k = 0; k < 4; ++k) s += (v[k][0] + v[k][1]) + (v[k][2] + v[k][3]);
#pragma unroll
        for (int o = 32; o >= 1; o >>= 1) s += __int_as_float(__builtin_amdgcn_ds_bpermute((lane ^ o) << 2, __float_as_int(s)));
        const float mean = s * (1.0f / 1024.0f);
        float q = 0.f;
#pragma unroll
        for (int k = 0; k < 4; ++k) { const f32x4 d = v[k] - mean; q += (d[0] * d[0] + d[1] * d[1]) + (d[2] * d[2] + d[3] * d[3]); }
#pragma unroll
        for (int o = 32; o >= 1; o >>= 1) q += __int_as_float(__builtin_amdgcn_ds_bpermute((lane ^ o) << 2, __float_as_int(q)));
        const float rstd = __builtin_amdgcn_rsqf(q * (1.0f / 1024.0f) + LN_EPS_F);
        bf16_t* xb = XB + (size_t)row * DM + lane * 4;
#pragma unroll
        for (int k = 0; k < 4; ++k) { const f32x4 y = (v[k] - mean) * rstd * gv[k] + bv[k];
            *(f32x4*)(xr + k * 256) = y;
            u32x2 w; w.x = cvt_pk_bf16(y[0], y[1]); w.y = cvt_pk_bf16(y[2], y[3]); *(u32x2*)(xb + k * 256) = w; }
    }
}
__device__ __forceinline__ void conv_phase(const bf16_t* U, bf16_t* UC, const float* cw, const float* cb) {
    const int nthr = gdim_() * NTHR;
    for (int item = bid_() * NTHR + tid_(); item < (M_TOK / 16) * 192; item += nthr) {
        const int rb = item / 192, cgp = item - rb * 192, c0 = cgp * 8, r0 = rb * 16;
        float w[4][8], bb[8];
#pragma unroll
        for (int k = 0; k < 4; ++k) { const f32x4 a = *(const f32x4*)(cw + k * DR + c0), b = *(const f32x4*)(cw + k * DR + c0 + 4);
#pragma unroll
            for (int j = 0; j < 4; ++j) { w[k][j] = a[j]; w[k][4 + j] = b[j]; } }
        { const f32x4 a = *(const f32x4*)(cb + c0), b = *(const f32x4*)(cb + c0 + 4);
#pragma unroll
          for (int j = 0; j < 4; ++j) { bb[j] = a[j]; bb[4 + j] = b[j]; } }
        float p1[8], p2[8], p3[8];
        const bf16_t* up = U + (size_t)r0 * DR + c0;
        if ((r0 & (SEQ - 1)) == 0) {
#pragma unroll
            for (int e = 0; e < 8; ++e) { p1[e] = 0.f; p2[e] = 0.f; p3[e] = 0.f; }
        } else {
            unpack8(*(const u32x4*)(up - DR), p1); unpack8(*(const u32x4*)(up - 2 * DR), p2); unpack8(*(const u32x4*)(up - 3 * DR), p3);
        }
        bf16_t* op = UC + (size_t)r0 * DR + c0;
#pragma unroll
        for (int i = 0; i < 16; ++i) {
            float cur[8], o[8]; unpack8(*(const u32x4*)(up + (size_t)i * DR), cur);
#pragma unroll
            for (int e = 0; e < 8; ++e) { o[e] = bb[e] + w[0][e] * p3[e] + w[1][e] * p2[e] + w[2][e] * p1[e] + w[3][e] * cur[e]; p3[e] = p2[e]; p2[e] = p1[e]; p1[e] = cur[e]; }
            *(u32x4*)(op + (size_t)i * DR) = pack8(o);
        }
    }
}
__device__ __forceinline__ void scan1_phase(const bf16_t* LA, const bf16_t* BB, float* SA, float* SH) {
    const int nthr = gdim_() * NTHR;
    for (int item = bid_() * NTHR + tid_(); item < 512 * 192; item += nthr) {
        const int bj = item / 192, cv = item - bj * 192;
        const bf16_t* pl = LA + (size_t)bj * 64 * DR + cv * 8; const bf16_t* pb = BB + (size_t)bj * 64 * DR + cv * 8;
        float A[8], h[8];
#pragma unroll
        for (int e = 0; e < 8; ++e) { A[e] = 1.f; h[e] = 0.f; }
#pragma unroll 4
        for (int i = 0; i < 64; ++i) {
            float la[8], b[8]; unpack8(*(const u32x4*)(pl + (size_t)i * DR), la); unpack8(*(const u32x4*)(pb + (size_t)i * DR), b);
#pragma unroll
            for (int e = 0; e < 8; ++e) { const float a = fast_exp(la[e]); A[e] *= a; h[e] = a * h[e] + b[e]; }
        }
        float* sa = SA + (size_t)bj * DR + cv * 8; float* sh = SH + (size_t)bj * DR + cv * 8;
        *(f32x4*)sa = (f32x4){A[0], A[1], A[2], A[3]}; *(f32x4*)(sa + 4) = (f32x4){A[4], A[5], A[6], A[7]};
        *(f32x4*)sh = (f32x4){h[0], h[1], h[2], h[3]}; *(f32x4*)(sh + 4) = (f32x4){h[4], h[5], h[6], h[7]};
    }
}
__device__ __forceinline__ void scan3_phase(const bf16_t* LA, const bf16_t* BB, const float* SA, const float* SH, bf16_t* YG) {
    const int nthr = gdim_() * NTHR;
    for (int item = bid_() * NTHR + tid_(); item < 512 * 192; item += nthr) {
        const int bj = item / 192, cv = item - bj * 192, j = bj & 63, b0 = bj - j;
        float h[8];
#pragma unroll
        for (int e = 0; e < 8; ++e) h[e] = 0.f;
#pragma unroll 4
        for (int i = 0; i < j; ++i) {
            const float* sa = SA + (size_t)(b0 + i) * DR + cv * 8; const float* sh = SH + (size_t)(b0 + i) * DR + cv * 8;
            const f32x4 a0 = *(const f32x4*)sa, a1 = *(const f32x4*)(sa + 4), h0 = *(const f32x4*)sh, h1 = *(const f32x4*)(sh + 4);
#pragma unroll
            for (int e = 0; e < 4; ++e) { h[e] = a0[e] * h[e] + h0[e]; h[4 + e] = a1[e] * h[4 + e] + h1[e]; }
        }
        const bf16_t* pl = LA + (size_t)bj * 64 * DR + cv * 8; const bf16_t* pb = BB + (size_t)bj * 64 * DR + cv * 8; bf16_t* py = YG + (size_t)bj * 64 * DR + cv * 8;
#pragma unroll 4
        for (int i = 0; i < 64; ++i) {
            float la[8], b[8], y[8], o[8]; unpack8(*(const u32x4*)(pl + (size_t)i * DR), la); unpack8(*(const u32x4*)(pb + (size_t)i * DR), b); unpack8(*(const u32x4*)(py + (size_t)i * DR), y);
#pragma unroll
            for (int e = 0; e < 8; ++e) { const float a = fast_exp(la[e]); h[e] = a * h[e] + b[e]; o[e] = h[e] * y[e]; }
            *(u32x4*)(py + (size_t)i * DR) = pack8(o);
        }
    }
}
__device__ __forceinline__ void pool_phase(const bf16_t* U, bf16_t* Z) {
    const int nthr = gdim_() * NTHR;
    for (int item = bid_() * NTHR + tid_(); item < (M_TOK / 32) * 128; item += nthr) {
        const int rb = item >> 7, cgp = item & 127, c0 = cgp * 8, w = 2 << (cgp >> 5), r0 = rb * 32, t0 = r0 & (SEQ - 1);
        const bf16_t* up = U + (size_t)r0 * DM + c0; bf16_t* zp = Z + (size_t)r0 * DM + c0;
        float sum[8];
#pragma unroll
        for (int e = 0; e < 8; ++e) sum[e] = 0.f;
        if (t0 != 0) for (int k = 1; k <= w; ++k) { float v[8]; unpack8(*(const u32x4*)(up - (size_t)k * DM), v);
#pragma unroll
            for (int e = 0; e < 8; ++e) sum[e] += v[e]; }
#pragma unroll 4
        for (int i = 0; i < 32; ++i) {
            const int t = t0 + i; float cur[8], o[8]; unpack8(*(const u32x4*)(up + (size_t)i * DM), cur);
#pragma unroll
            for (int e = 0; e < 8; ++e) sum[e] += cur[e];
            if (t >= w) { float old[8]; unpack8(*(const u32x4*)(up + (size_t)(i - w) * DM), old);
#pragma unroll
                for (int e = 0; e < 8; ++e) sum[e] -= old[e]; }
            const int cnt = (t + 1 < w) ? (t + 1) : w; const float rc = 1.0f / (float)cnt;
#pragma unroll
            for (int e = 0; e < 8; ++e) o[e] = sum[e] * rc - cur[e];
            *(u32x4*)(zp + (size_t)i * DM) = pack8(o);
        }
    }
}


#define XB_TMO      128
#define XB_XCNT(j)  (256  + 64 * (j))
#define XB_XSUB(j)  (1280 + 64 * (j))
#define XB_XGEN(j)  (2304 + 64 * (j))
#define XB_TOP      3328
#define XB_TOPGEN   3392
#define XCD_BAR_WORDS 3456
#define XB_SPIN_CAP (1u << 20)
__device__ __forceinline__ unsigned xb_ld(unsigned* p)              { return __hip_atomic_load(p, __ATOMIC_RELAXED, __HIP_MEMORY_SCOPE_AGENT); }
__device__ __forceinline__ unsigned xb_add(unsigned* p, unsigned v) { return __hip_atomic_fetch_add(p, v, __ATOMIC_RELAXED, __HIP_MEMORY_SCOPE_AGENT); }
__device__ __forceinline__ unsigned xb_xcc_id() { return (unsigned)__builtin_amdgcn_s_getreg((3 << 11) | 20) & 0xFu; }
#define XB_SPIN(cond, bar) do { unsigned _sp = 0; while (cond) { __builtin_amdgcn_s_sleep(1); \
    if ((++_sp & 255u) == 0u) { if (xb_ld(&(bar)[XB_TMO])) break; if (_sp > XB_SPIN_CAP) { atomicAdd(&(bar)[XB_TMO], 1u); break; } } } } while (0)
struct XcdBarrier { unsigned* bar; unsigned x; volatile LAS unsigned* st; };
__device__ __forceinline__ XcdBarrier xcd_barrier_post(unsigned* bar, volatile LAS unsigned* st) {
    XcdBarrier b; b.bar = bar; b.x = xb_xcc_id(); b.st = st;
    if (threadIdx.x == 0) (void)xb_add(&bar[XB_XCNT(b.x)], 1u);
    return b;
}
__device__ __forceinline__ void xcd_barrier_complete(unsigned* bar, unsigned x, unsigned& nloc, unsigned& nx) {
    const unsigned G = gridDim.x * gridDim.y * gridDim.z;
    unsigned sum, cnt, mine, sp = 0u;
    for (;;) {
        sum = 0u; cnt = 0u; mine = 0u;
#pragma unroll
        for (unsigned j = 0; j < 16; ++j) { const unsigned c = xb_ld(&bar[XB_XCNT(j)]); sum += c; cnt += (c > 0u) ? 1u : 0u; mine = (j == x) ? c : mine; }
        if (sum == G) break;
        __builtin_amdgcn_s_sleep(1);
        if ((++sp & 255u) == 0u) { if (xb_ld(&bar[XB_TMO])) break; if (sp > XB_SPIN_CAP) { atomicAdd(&bar[XB_TMO], 1u); break; } }
    }
    nloc = mine > 0u ? mine : 1u; nx = cnt > 0u ? cnt : 1u;
}
__device__ __forceinline__ void xcd_barrier(const XcdBarrier& b) {
    asm volatile("s_waitcnt vmcnt(0)" ::: "memory");
    __syncthreads();
    if (threadIdx.x == 0) {
        unsigned* bar = b.bar;
        __builtin_amdgcn_s_waitcnt(0);
        unsigned nloc = b.st[0], nx = b.st[1];
        if (nloc == 0u) { xcd_barrier_complete(bar, b.x, nloc, nx); b.st[0] = nloc; b.st[1] = nx; }
        const unsigned old = xb_add(&bar[XB_XSUB(b.x)], 1u);
        const unsigned gen = old / nloc;
        if (old + 1u == (gen + 1u) * nloc) {
            __builtin_amdgcn_fence(__ATOMIC_RELEASE, "agent");
            asm volatile("s_waitcnt vmcnt(0)" ::: "memory");
            const unsigned og = xb_add(&bar[XB_TOP], 1u);
            const unsigned tg = og / nx;
            if (og + 1u == (tg + 1u) * nx) xb_add(&bar[XB_TOPGEN], 1u);
            else XB_SPIN(xb_ld(&bar[XB_TOPGEN]) == tg, bar);
            __builtin_amdgcn_fence(__ATOMIC_ACQUIRE, "agent");
            xb_add(&bar[XB_XGEN(b.x)], 1u);
            asm volatile("s_waitcnt vmcnt(0)" ::: "memory");
        } else {
            XB_SPIN(xb_ld(&bar[XB_XGEN(b.x)]) == gen, bar);
            __builtin_amdgcn_fence(__ATOMIC_ACQUIRE, "agent");
            asm volatile("s_waitcnt vmcnt(0)" ::: "memory");
        }
    }
    __syncthreads();
}

__global__ void __launch_bounds__(NTHR, 2) mk_fwd(Args args) {
    extern __shared__ __attribute__((aligned(16))) unsigned char shm[];
    LAS unsigned char* lds = (LAS unsigned char*)shm;
    cg::grid_group grid = cg::this_grid();
    const int lo = args.ph_lo, hi = args.ph_hi;
    const kptr_t kp0 = (kptr_t)__builtin_amdgcn_kernarg_segment_ptr();
    volatile LAS unsigned* xst = (volatile LAS unsigned*)(lds + LDS_STAGE);
    if (threadIdx.x < 16) xst[threadIdx.x] = 0u;
    __syncthreads();
    const XcdBarrier xb = xcd_barrier_post((unsigned*)(kws(kp0) + OFF_BAR), xst);
    int ph = 0;
#define RUN (ph >= lo && ph < hi)
#define SEAM do { if (ph >= lo && ph + 1 < hi) { if (ph == lo) grid.sync(); else xcd_barrier(xb); } ++ph; } while (0)
#define PH_SETUP kptr_t kp = kp0; asm volatile("" : "+s"(kp)); unsigned char* const ws = kws(kp); const int G = gdim_(), bid = bid_(); (void)G; (void)bid;
#define WSP(T, off) ((T*)(ws + (off)))

    if (RUN) {
        PH_SETUP
        cvt_rows(kin(kp, 0), WSP(bf16_t, OFF_B3), (size_t)M_TOK * DM / 8);
        conv_wmix(lds, kp, 0, WSP(bf16_t, OFF_WMIX));
        if (bid == 0) { const float* lam = kin(kp, 9); float* nsp = WSP(float, OFF_NSP); for (int i = tid_(); i < 2 * DR; i += NTHR) nsp[i] = -8.0f * log1pf(expf(-lam[i])); }
    }
    SEAM;
#pragma unroll 1
    for (int layer = 0; layer < 4; ++layer) {
        const bool isA = !(layer & 1); const int slot = layer >> 1;
        if (RUN) {
            PH_SETUP
            pg8::Gemm g{WSP(bf16_t, OFF_B3), WSP(bf16_t, OFF_WMIX), M_TOK, isA ? 2 * DR : DM, DM, DM, 0, 0};
            pg8::StaticOrder S; S.init(g.M, g.N, G, bid);
            EpiG1 E{WSP(bf16_t, OFF_B1), isA ? DR : DM, WSP(bf16_t, OFF_B2), DR, isA ? 6 : 4};
            pg8::gemm_phase(lds, g, S, E);
        }
        SEAM;
        if (isA) {
            if (RUN) {
                PH_SETUP
                conv_phase(WSP(bf16_t, OFF_B1), WSP(bf16_t, OFF_B3), kin(kp, 3) + (size_t)slot * 4 * DR, kin(kp, 4) + (size_t)slot * DR);
                conv_wmlp(lds, kp, layer, WSP(bf16_t, OFF_WMLP));
            }
            SEAM;
            if (RUN) {
                PH_SETUP
                pg8::Gemm g{WSP(bf16_t, OFF_B3), WSP(bf16_t, OFF_WMIX) + WA_GT, M_TOK, 12 * 256, 256, DR, 1, 256};
                pg8::StaticOrder S; S.init(g.M, g.N, G, bid);
                EpiGates E{WSP(bf16_t, OFF_B1), WSP(bf16_t, OFF_B4), WSP(bf16_t, OFF_B3), kin(kp, 6) + (size_t)slot * DR, kin(kp, 8) + (size_t)slot * DR, WSP(float, OFF_NSP) + (size_t)slot * DR};
                pg8::gemm_phase(lds, g, S, E);
            }
            SEAM;
            if (RUN) { PH_SETUP scan1_phase(WSP(bf16_t, OFF_B1), WSP(bf16_t, OFF_B4), WSP(float, OFF_SUMA), WSP(float, OFF_SUMH)); }
            SEAM;
            if (RUN) { PH_SETUP scan3_phase(WSP(bf16_t, OFF_B1), WSP(bf16_t, OFF_B4), WSP(float, OFF_SUMA), WSP(float, OFF_SUMH), WSP(bf16_t, OFF_B2)); }
            SEAM;
        } else {
            if (RUN) {
                PH_SETUP
                pool_phase(WSP(bf16_t, OFF_B1), WSP(bf16_t, OFF_B2));
                conv_wmlp(lds, kp, layer, WSP(bf16_t, OFF_WMLP));
            }
            SEAM;
            if (RUN) {
                PH_SETUP
                pg8::Gemm g{WSP(bf16_t, OFF_B2), WSP(bf16_t, OFF_WMIX) + WB_GT, M_TOK, DM, 256, DM, 0, 256};
                pg8::StaticOrder S; S.init(g.M, g.N, G, bid);
                EpiStore<2> E{WSP(bf16_t, OFF_B3), DM, kin(kp, 13) + (size_t)slot * DM, kin(kp, 14) + (size_t)slot * DM};
                pg8::gemm_phase(lds, g, S, E);
            }
            SEAM;
        }
        if (RUN) {
            PH_SETUP
            float* const X = kout(kp);
            pg8::Gemm g{isA ? WSP(bf16_t, OFF_B2) : WSP(bf16_t, OFF_B3), WSP(bf16_t, OFF_WMIX) + (isA ? WA_OUT : WB_OUT), M_TOK, DM, isA ? DR : DM, isA ? DR : DM, 0, 0};
            pg8::StaticOrder S; S.init(g.M, g.N, G, bid);
            EpiResid E{layer == 0 ? kin(kp, 0) : (const float*)X, X};
            pg8::gemm_phase(lds, g, S, E);
        }
        SEAM;
        if (RUN) {
            PH_SETUP
            ln_rows(kout(kp), WSP(bf16_t, OFF_XB), kin(kp, 16) + (size_t)layer * DM, kin(kp, 17) + (size_t)layer * DM);
            cvt_rows(kin(kp, 1) + (size_t)layer * M_TOK * PLE, WSP(bf16_t, OFF_PB), (size_t)M_TOK * PLE / 8);
        }
        SEAM;
        if (RUN) {
            PH_SETUP
            pg8::Gemm g{WSP(bf16_t, OFF_XB), WSP(bf16_t, OFF_WMLP) + WM_W1, M_TOK, DFF, DM, DM, 0, 0};
            pg8::StaticOrder S; S.init(g.M, g.N, G, bid);
            EpiStore<1> E{WSP(bf16_t, OFF_B1), DFF, nullptr, nullptr};
            pg8::gemm_phase(lds, g, S, E);
        }
        SEAM;
        if (RUN) {
            PH_SETUP
            float* const X = kout(kp);
            pg8::Gemm g{WSP(bf16_t, OFF_B1), WSP(bf16_t, OFF_WMLP) + WM_W2, M_TOK, DM, DFF, DFF, 0, 0};
            pg8::StaticOrder S; S.init(g.M, g.N, G, bid);
            EpiResid E{(const float*)X, X};
            pg8::gemm_phase(lds, g, S, E);
        }
        SEAM;
        if (RUN) {
            PH_SETUP
            ln_rows(kout(kp), WSP(bf16_t, OFF_XB), kin(kp, 20) + (size_t)layer * DM, kin(kp, 21) + (size_t)layer * DM);
            if (layer < 3) conv_wmix(lds, kp, layer + 1, WSP(bf16_t, OFF_WMIX));
        }
        SEAM;
        if (RUN) {
            {
                PH_SETUP
                pg8::Gemm g{WSP(bf16_t, OFF_PB), WSP(bf16_t, OFF_WMLP) + WM_PLE, M_TOK, DM, PLE, PLE, 0, 0};
                pg8::StaticOrder S; S.init(g.M, g.N, G, bid);
                EpiStore<0> E{WSP(bf16_t, OFF_B1), DM, nullptr, nullptr};
                pg8::gemm_phase(lds, g, S, E);
            }
            {
                PH_SETUP
                pg8::Gemm g{WSP(bf16_t, OFF_XB), WSP(bf16_t, OFF_WMLP) + WM_PG, M_TOK, DM, DM, DM, 0, 0};
                pg8::StaticOrder S; S.init(g.M, g.N, G, bid);
                EpiPle E{kout(kp), WSP(bf16_t, OFF_B1), kin(kp, 24) + (size_t)layer * DM, WSP(bf16_t, OFF_B3)};
                pg8::gemm_phase(lds, g, S, E);
            }
        }
        SEAM;
    }
#undef RUN
#undef SEAM
#undef PH_SETUP
#undef WSP
}

constexpr int N_PHASES = 1 + 2 * (11 + 9);

extern "C" void kernel_launch(void* const* d_in, const int* in_sizes, int n_in, void* d_out, int out_size, void* d_ws, size_t ws_size, hipStream_t stream) {
    static int grid = 0;
    if (grid == 0) {
        int dev = 0, cus = 0, per_cu = 0;
        hipGetDevice(&dev);
        hipDeviceGetAttribute(&cus, hipDeviceAttributeMultiprocessorCount, dev);
        if (hipFuncSetAttribute((const void*)mk_fwd, hipFuncAttributeMaxDynamicSharedMemorySize, LDS_BYTES) != hipSuccess) fprintf(stderr, "kernel_launch: hipFuncSetAttribute failed\n");
        if (hipOccupancyMaxActiveBlocksPerMultiprocessor(&per_cu, (const void*)mk_fwd, NTHR, LDS_BYTES) != hipSuccess || per_cu < 1) fprintf(stderr, "kernel_launch: occupancy query says %d blocks per CU\n", per_cu);
        (void)hipGetLastError();
        grid = cus > 0 ? cus : 256;
    }
    if (hipMemsetAsync((unsigned char*)d_ws + OFF_BAR, 0, XCD_BAR_WORDS * sizeof(unsigned), stream) != hipSuccess) fprintf(stderr, "kernel_launch: memset of the barrier words failed\n");
    Args a{};
    for (int i = 0; i < 25; ++i) a.in[i] = (const float*)d_in[i];
    a.out = (float*)d_out; a.ws = (unsigned char*)d_ws;
    void* params[] = {&a};
#if ONE_LAUNCH
    a.ph_lo = 0; a.ph_hi = N_PHASES;
    hipError_t e = hipLaunchCooperativeKernel((const void*)mk_fwd, dim3(grid), dim3(NTHR), params, LDS_BYTES, stream);
    if (e != hipSuccess) fprintf(stderr, "kernel_launch: cooperative launch failed: %s (grid %d)\n", hipGetErrorString(e), grid);
#else
    for (int p = 0; p < N_PHASES; ++p) {
        a.ph_lo = p; a.ph_hi = p + 1;
        hipError_t e = hipLaunchCooperativeKernel((const void*)mk_fwd, dim3(grid), dim3(NTHR), params, LDS_BYTES, stream);
        if (e != hipSuccess) { fprintf(stderr, "kernel_launch: launch %d failed: %s (grid %d)\n", p, hipGetErrorString(e), grid); break; }
    }
#endif
}
```
